# Optimizing an MI355X kernel written in HIP

```python
import math
import jax, jax.numpy as jnp
from jax import lax
import numpy as np

D_MODEL = 1024
BATCH = 32
SEQ = 2048
DEPTH = 1

EPS = 1e-6
NEG = -1e30
D_FF = 2816

MLA_HEADS = 8
Q_LORA = 256
KV_LORA = 128
QK_NOPE = 64
QK_ROPE = 32
V_HEAD = 64
ROPE_THETA = 10000.0
Q_BLOCK = 128

SWA_HEADS = 8
SWA_KV_HEADS = 2
SWA_HEAD_DIM = 64
WINDOW = 128

REL_BUCKETS = 32
REL_MAX_DIST = 128

MLA_OUT = MLA_HEADS * V_HEAD
SWA_OUT = SWA_HEADS * SWA_HEAD_DIM
D_MIX = MLA_OUT + SWA_OUT
IN_WIDTHS = (Q_LORA, KV_LORA + QK_ROPE, SWA_HEADS * SWA_HEAD_DIM,
             SWA_KV_HEADS * SWA_HEAD_DIM, SWA_KV_HEADS * SWA_HEAD_DIM)
D_IN = sum(IN_WIDTHS)
IN_SPLITS = tuple(int(s) for s in np.cumsum(IN_WIDTHS)[:-1])

kernel_name = "hymba_mla_swa_macaron_t5"


def rmsnorm(x, g):
    xf = x.astype(jnp.float32)
    y = xf * lax.rsqrt(jnp.mean(xf * xf, axis=-1, keepdims=True) + EPS)
    return (y * g.astype(jnp.float32)).astype(x.dtype)


def swiglu(x, w_gate, w_up, w_down):
    return (jax.nn.silu(x @ w_gate) * (x @ w_up)) @ w_down


def rope(x, cos, sin):
    half = x.shape[-1] // 2
    xf = x.astype(jnp.float32)
    x1, x2 = xf[..., :half], xf[..., half:]
    return jnp.concatenate([x1 * cos - x2 * sin, x2 * cos + x1 * sin], axis=-1).astype(x.dtype)


def t5_bucket(dist):
    n = jnp.maximum(dist, 0)
    max_exact = REL_BUCKETS // 2
    nf = jnp.maximum(n, 1).astype(jnp.float32)
    large = max_exact + (jnp.log(nf / max_exact) / math.log(REL_MAX_DIST / max_exact)
                         * (REL_BUCKETS - max_exact)).astype(jnp.int32)
    large = jnp.minimum(large, REL_BUCKETS - 1)
    return jnp.where(n < max_exact, n, large)


def mla_group(c_q, ckv_pe, g_q_a, w_q_b, g_kv_a, w_kv_b):
    B, S, _ = c_q.shape
    pos = jnp.arange(S, dtype=jnp.float32)
    inv_freq = ROPE_THETA ** (-jnp.arange(0, QK_ROPE, 2, dtype=jnp.float32) / QK_ROPE)
    ang = pos[:, None] * inv_freq[None, :]
    cos, sin = jnp.cos(ang), jnp.sin(ang)

    q = (rmsnorm(c_q, g_q_a) @ w_q_b).reshape(B, S, MLA_HEADS, QK_NOPE + QK_ROPE)
    q_nope = q[..., :QK_NOPE]
    q_pe = rope(q[..., QK_NOPE:], cos[:, None, :], sin[:, None, :])
    c_kv = ckv_pe[..., :KV_LORA]
    k_pe = rope(ckv_pe[..., KV_LORA:], cos, sin)
    kv = (rmsnorm(c_kv, g_kv_a) @ w_kv_b).reshape(B, S, MLA_HEADS, QK_NOPE + V_HEAD)
    k_nope, v = kv[..., :QK_NOPE], kv[..., QK_NOPE:]
    scale = (QK_NOPE + QK_ROPE) ** -0.5

    nb = S // Q_BLOCK
    qn_b = q_nope.reshape(B, nb, Q_BLOCK, MLA_HEADS, QK_NOPE).transpose(1, 0, 2, 3, 4)
    qp_b = q_pe.reshape(B, nb, Q_BLOCK, MLA_HEADS, QK_ROPE).transpose(1, 0, 2, 3, 4)
    kpos = jnp.arange(S)

    def block(args):
        qn, qp, i = args
        s = (jnp.einsum('bqhd,bkhd->bhqk', qn, k_nope)
             + jnp.einsum('bqhr,bkr->bhqk', qp, k_pe)).astype(jnp.float32) * scale
        qpos = i * Q_BLOCK + jnp.arange(Q_BLOCK)
        causal = kpos[None, :] <= qpos[:, None]
        s = jnp.where(causal[None, None], s, NEG)
        p = jax.nn.softmax(s, axis=-1).astype(v.dtype)
        return jnp.einsum('bhqk,bkhd->bqhd', p, v)

    o = lax.map(block, (qn_b, qp_b, jnp.arange(nb)))
    return o.transpose(1, 0, 2, 3, 4).reshape(B, S, MLA_OUT)


def swa_group(q, k, v, sinks, rel_bias):
    B, S, _ = q.shape
    nb = S // WINDOW
    G = SWA_HEADS // SWA_KV_HEADS
    dh = SWA_HEAD_DIM
    q = q.reshape(B, nb, WINDOW, SWA_KV_HEADS, G, dh)
    k = k.reshape(B, nb, WINDOW, SWA_KV_HEADS, dh)
    v = v.reshape(B, nb, WINDOW, SWA_KV_HEADS, dh)

    def band(t):
        prev = jnp.pad(t, ((0, 0), (1, 0), (0, 0), (0, 0), (0, 0)))[:, :-1]
        return jnp.concatenate([prev, t], axis=2)

    kb, vb = band(k), band(v)
    s = jnp.einsum('bnqhgd,bnkhd->bnhgqk', q, kb).astype(jnp.float32) * (dh ** -0.5)

    qi = jnp.arange(WINDOW)[:, None]
    kj = jnp.arange(2 * WINDOW)[None, :]
    dist = qi + WINDOW - kj
    bias = rel_bias[t5_bucket(dist)]
    bias = bias.transpose(2, 0, 1).reshape(SWA_KV_HEADS, G, WINDOW, 2 * WINDOW)
    kpos = jnp.arange(nb)[:, None, None] * WINDOW - WINDOW + kj[None]
    valid = (dist >= 0)[None] & (dist < WINDOW)[None] & (kpos >= 0)

    s = s + bias.astype(jnp.float32)[None, None]
    s = jnp.where(valid[None, :, None, None], s, NEG)
    sink = sinks.astype(jnp.float32).reshape(SWA_KV_HEADS, G)[None, None, :, :, None, None]
    m = jnp.maximum(jnp.max(s, axis=-1, keepdims=True), sink)
    p = jnp.exp(s - m)
    denom = jnp.sum(p, axis=-1, keepdims=True) + jnp.exp(sink - m)
    o = jnp.einsum('bnhgqk,bnkhd->bnqhgd', (p / denom).astype(vb.dtype), vb)
    return o.reshape(B, S, SWA_OUT)


def setup_inputs(seed: int = 0) -> dict:
    key = jax.random.key(seed)
    ks = iter(jax.random.split(key, 32))
    L = DEPTH

    def w(shape, fan_in):
        return jax.random.normal(next(ks), shape, jnp.float32) * fan_in ** -0.5

    def gain(shape):
        return 1.0 + 0.02 * jax.random.normal(next(ks), shape, jnp.float32)

    return {
        "x": jax.random.normal(next(ks), (BATCH, SEQ, D_MODEL), jnp.float32),
        "g_ffn1": gain((L, D_MODEL)),
        "w_ffn1_gate": w((L, D_MODEL, D_FF), D_MODEL),
        "w_ffn1_up": w((L, D_MODEL, D_FF), D_MODEL),
        "w_ffn1_down": w((L, D_FF, D_MODEL), D_FF),
        "g_mix": gain((L, D_MODEL)),
        "w_in": w((L, D_MODEL, D_IN), D_MODEL),
        "g_q_a": gain((L, Q_LORA)),
        "w_q_b": w((L, Q_LORA, MLA_HEADS * (QK_NOPE + QK_ROPE)), Q_LORA),
        "g_kv_a": gain((L, KV_LORA)),
        "w_kv_b": w((L, KV_LORA, MLA_HEADS * (QK_NOPE + V_HEAD)), KV_LORA),
        "attn_sinks": 0.5 * jax.random.normal(next(ks), (L, SWA_HEADS), jnp.float32),
        "rel_bias": 0.5 * jax.random.normal(next(ks), (REL_BUCKETS, SWA_HEADS), jnp.float32),
        "g_out_mla": gain((L, MLA_OUT)),
        "g_out_swa": gain((L, SWA_OUT)),
        "w_o": w((L, D_MIX, D_MODEL), D_MIX),
        "g_ffn2": gain((L, D_MODEL)),
        "w_ffn2_gate": w((L, D_MODEL, D_FF), D_MODEL),
        "w_ffn2_up": w((L, D_MODEL, D_FF), D_MODEL),
        "w_ffn2_down": w((L, D_FF, D_MODEL), D_FF),
        "g_final": gain((D_MODEL,)),
    }


def reference(x, g_ffn1, w_ffn1_gate, w_ffn1_up, w_ffn1_down, g_mix, w_in, g_q_a, w_q_b,
              g_kv_a, w_kv_b, attn_sinks, rel_bias, g_out_mla, g_out_swa, w_o, g_ffn2,
              w_ffn2_gate, w_ffn2_up, w_ffn2_down, g_final):
    h = x
    for l in range(DEPTH):
        h = h + 0.5 * swiglu(rmsnorm(h, g_ffn1[l]), w_ffn1_gate[l], w_ffn1_up[l], w_ffn1_down[l])
        u = rmsnorm(h, g_mix[l])
        proj = u @ w_in[l]
        c_q, ckv_pe, q_s, k_s, v_s = jnp.split(proj, IN_SPLITS, axis=-1)
        o_mla = mla_group(c_q, ckv_pe, g_q_a[l], w_q_b[l], g_kv_a[l], w_kv_b[l])
        o_swa = swa_group(q_s, k_s, v_s, attn_sinks[l], rel_bias)
        o = jnp.concatenate([rmsnorm(o_mla, g_out_mla[l]), rmsnorm(o_swa, g_out_swa[l])], axis=-1)
        h = h + o @ w_o[l]
        h = h + 0.5 * swiglu(rmsnorm(h, g_ffn2[l]), w_ffn2_gate[l], w_ffn2_up[l], w_ffn2_down[l])
    return rmsnorm(h, g_final)
```

```cpp
#include <hip/hip_runtime.h>
#include <hip/hip_cooperative_groups.h>
#include <cstdio>
#include <cstdint>
namespace cg = cooperative_groups;

#ifndef MK_ONE_LAUNCH
#define MK_ONE_LAUNCH 1
#endif

#define LAS __attribute__((address_space(3)))
typedef unsigned short bf16_t;
typedef short bf16x8 __attribute__((ext_vector_type(8)));
typedef short s16x4 __attribute__((ext_vector_type(4)));
typedef float f32x4 __attribute__((ext_vector_type(4)));
typedef float f32x2 __attribute__((ext_vector_type(2)));
typedef unsigned u32x4 __attribute__((ext_vector_type(4)));
typedef unsigned u32x2 __attribute__((ext_vector_type(2)));

constexpr int MTOK = 65536, DM = 1024, DFF = 2816, SEQ = 2048, NPROJ = 1280, NQ = 768, NKV = 1024;
constexpr float EPS = 1e-6f;
constexpr float LOG2E = 1.4426950408889634f;
constexpr int PC_KPE = 384, PC_QS = 512, PC_KS = 1024, PC_VS = 1152;

constexpr size_t MiB = 1u << 20;
constexpr size_t WS_ROPE = 0;
constexpr size_t WS_BIAS = 512 * 1024;
constexpr size_t WS_BAR = 1 * MiB, BAR_BYTES = 32768;
constexpr size_t WS_STATS = 4 * MiB;
constexpr size_t WS_PQ = 8 * MiB;
constexpr size_t WS_PKV = 9 * MiB;
constexpr size_t WS_PO = 10 * MiB;
constexpr size_t WS_W1GU = 16 * MiB, WS_W1D = 27 * MiB, WS_W2GU = 33 * MiB, WS_W2D = 44 * MiB, WS_WIN = 50 * MiB, WS_WQB = 53 * MiB, WS_WKVB = 54 * MiB, WS_WO = 55 * MiB;
constexpr size_t WS_HID = 64 * MiB;
constexpr size_t WS_PROJ = 64 * MiB;
constexpr size_t WS_QMLA = 224 * MiB;
constexpr size_t WS_KV = 416 * MiB;
constexpr size_t WS_O = 544 * MiB;
constexpr size_t WS_HB = 672 * MiB;
constexpr size_t WS_END = 800 * MiB;

constexpr int LDS_BYTES = 147456;

typedef __bf16 bf16x2_t __attribute__((ext_vector_type(2)));
__device__ __forceinline__ unsigned cvt_pk_bf16(float lo, float hi) { const f32x2 v = {lo, hi}; const bf16x2_t b = __builtin_convertvector(v, bf16x2_t); return __builtin_bit_cast(unsigned, b); }
__device__ __forceinline__ float wave_sum(float v) {
#pragma unroll
    for (int o = 1; o < 64; o <<= 1) v += __shfl_xor(v, o);
    return v;
}
__device__ __forceinline__ float sum4(f32x4 v) { return (v.x + v.y) + (v.z + v.w); }
__device__ __forceinline__ float sq4(f32x4 v) { return (v.x * v.x + v.y * v.y) + (v.z * v.z + v.w * v.w); }
__device__ __forceinline__ float quad_sum(float s) {
    auto a = __builtin_amdgcn_permlane16_swap(__float_as_uint(s), __float_as_uint(s), false, false); s = __uint_as_float(a[0]) + __uint_as_float(a[1]);
    auto b = __builtin_amdgcn_permlane32_swap(__float_as_uint(s), __float_as_uint(s), false, false); return __uint_as_float(b[0]) + __uint_as_float(b[1]);
}
__device__ __forceinline__ float quad_max(float s) {
    auto a = __builtin_amdgcn_permlane16_swap(__float_as_uint(s), __float_as_uint(s), false, false); s = fmaxf(__uint_as_float(a[0]), __uint_as_float(a[1]));
    auto b = __builtin_amdgcn_permlane32_swap(__float_as_uint(s), __float_as_uint(s), false, false); return fmaxf(__uint_as_float(b[0]), __uint_as_float(b[1]));
}
__device__ __forceinline__ float rsq(float x) { return __builtin_amdgcn_rsqf(x); }

namespace pg8 {
constexpr int BM = 256, BK = 64, HALF = 128, HTB = HALF * BK * 2, STAGE_BYTES = 8 * HTB, NXCD = 8, WGM = 8;
__host__ __device__ __forceinline__ int lds_byte(int r, int c) { const int st = (r >> 4) * 2 + (c >> 5), rr = r & 15, cc = c & 31, ob = rr * 64 + cc * 2; return st * 1024 + (ob ^ (((ob >> 9) & 1) << 5)); }
__host__ __device__ __forceinline__ void stage_rc(int b, int& R, int& C) { const int st = b / 1024, sb = b % 1024, swz = sb ^ (((sb >> 9) & 1) << 5); R = (st >> 1) * 16 + swz / 64; C = (st & 1) * 32 + (swz % 64) / 2; }
__host__ __device__ __forceinline__ int perm32(int rho) { const int n = rho >> 4, i = rho & 15; return 8 * (i >> 2) + 4 * n + (i & 3); }

struct Unit { int pm, pn; };
struct Gemm { const bf16_t* A; const bf16_t* Bt; int M, N, K, lda, ldb; };

struct StaticOrder {
    int nM, nN, nwg, G, c;
    __device__ void init(int M, int N, int G_, int c_) { nM = M / BM; nN = N / BM; nwg = nM * nN; G = G_; c = c_; }
    __device__ bool next(int i, Unit& u) const {
        const long L = (long)i * G + c; if (L >= nwg) return false;
        int wgid = (int)L; { const int q = nwg / NXCD, r = nwg % NXCD, xcd = wgid % NXCD, off = wgid / NXCD; wgid = (xcd < r ? xcd * (q + 1) : r * (q + 1) + (xcd - r) * q) + off; }
        const int nig = WGM * nN, gid = wgid / nig, fm = gid * WGM, gsz = (nM - fm) < WGM ? (nM - fm) : WGM;
        u.pm = fm + ((wgid % nig) % gsz); u.pn = (wgid % nig) / gsz; return true;
    }
};
struct NoMid { static constexpr bool ON = false; __device__ __forceinline__ void apply(f32x4 (&)[2][2][4][2], const Unit&, int, int, int) const {} };

template <class Epi, class Mid>
__device__ __forceinline__ void gemm_phase(LAS unsigned char* lds, const Gemm g, const StaticOrder& S, const Epi& E, const Mid& Md) {
    const int tid = threadIdx.x, wid = __builtin_amdgcn_readfirstlane(tid >> 6), lane = tid & 63, wr = wid >> 2, wc = wid & 3, fr = lane & 15, fq = lane >> 4;
    int K = g.K; asm volatile("" : "+s"(K)); const int nt = K / BK;
    unsigned voffA[2], voffB[2];
#pragma unroll
    for (int i = 0; i < 2; ++i) { int R, C; stage_rc(tid * 16 + i * 8192, R, C); const int Rb = Epi::PERM ? ((R & ~31) + perm32(R & 31)) : R;
        voffA[i] = (unsigned)(R * g.lda + C) * 2u; voffB[i] = (unsigned)(Rb * g.ldb + C) * 2u; }
    const size_t kstep = (size_t)(BK * 2);
    const size_t hsA = (size_t)HALF * g.lda * 2, hsB = (size_t)HALF * g.ldb * 2, tsA = 2 * hsA, tsB = 2 * hsB;
    const unsigned ldsw = (unsigned)wid * 1024u;
    const int aoff = lds_byte(wr * 64 + fr, fq * 8), boff = lds_byte(wc * 32 + fr, fq * 8);
#define PG8_SA(b, h) (((b) * 2 + (h)) * HTB)
#define PG8_SB(b, h) ((4 + (b) * 2 + (h)) * HTB)
#define PG8_STAGE(bufoff, gbase, voff) do { _Pragma("unroll") for (int _i = 0; _i < 2; ++_i) \
        __builtin_amdgcn_global_load_lds((const unsigned*)((const char*)(gbase) + (voff)[_i]), (LAS unsigned*)(lds + (bufoff) + ldsw + _i * 8192), 16, 0, 0); } while (0)
#define PG8_LDA(dst, b, h) do { _Pragma("unroll") for (int m = 0; m < 4; ++m) _Pragma("unroll") for (int k = 0; k < 2; ++k) dst[m][k] = *(const LAS bf16x8*)(lds + PG8_SA(b, h) + aoff + m * 2048 + k * 1024); } while (0)
#define PG8_LDB(dst, b, h) do { _Pragma("unroll") for (int n = 0; n < 2; ++n) _Pragma("unroll") for (int k = 0; k < 2; ++k) dst[n][k] = *(const LAS bf16x8*)(lds + PG8_SB(b, h) + boff + n * 2048 + k * 1024); } while (0)
#define PG8_MMA(ai, bj, At, Bt) do { __builtin_amdgcn_s_setprio(1); _Pragma("unroll") for (int m = 0; m < 4; ++m) _Pragma("unroll") for (int n = 0; n < 2; ++n) _Pragma("unroll") for (int k = 0; k < 2; ++k) \
        acc[ai][bj][m][n] = __builtin_amdgcn_mfma_f32_16x16x32_bf16(Bt[n][k], At[m][k], acc[ai][bj][m][n], 0, 0, 0); __builtin_amdgcn_s_setprio(0); } while (0)
#define PG8_WAIT_V(n) asm volatile("s_waitcnt vmcnt(" #n ")" ::: "memory")
#define PG8_WAIT_L(n) asm volatile("s_waitcnt lgkmcnt(" #n ")" ::: "memory")
#define PG8_BAR __builtin_amdgcn_s_barrier()
#define PG8_SCHED __builtin_amdgcn_sched_barrier(0)
    Unit cur, nxt; int ui = 0;
    if (!S.next(0, cur)) return;
    f32x4 acc[2][2][4][2];
#pragma unroll
    for (int a = 0; a < 2; ++a)
#pragma unroll
        for (int b = 0; b < 2; ++b)
#pragma unroll
            for (int m = 0; m < 4; ++m)
#pragma unroll
                for (int n = 0; n < 2; ++n) acc[a][b][m][n] = (f32x4){0.f, 0.f, 0.f, 0.f};
    bf16x8 At[4][2], B0[2][2], B1[2][2];
    const char* cA = (const char*)g.A + (size_t)cur.pm * tsA; const char* cB = (const char*)g.Bt + (size_t)cur.pn * tsB;
    PG8_STAGE(PG8_SB(0, 0), cB, voffB); PG8_STAGE(PG8_SB(0, 1), cB + hsB, voffB); PG8_STAGE(PG8_SA(0, 0), cA, voffA); PG8_STAGE(PG8_SA(0, 1), cA + hsA, voffA);
    if (wr == 1) PG8_BAR;
    PG8_WAIT_V(2); PG8_BAR;
    PG8_STAGE(PG8_SB(1, 0), cB + kstep, voffB); PG8_STAGE(PG8_SA(1, 0), cA + kstep, voffA); PG8_STAGE(PG8_SB(1, 1), cB + hsB + kstep, voffB);
    PG8_WAIT_V(6); PG8_BAR;
    for (;;) {
        const bool has_next = S.next(ui + 1, nxt);
        const char* nA = has_next ? (const char*)g.A + (size_t)nxt.pm * tsA : cA; const char* nB = has_next ? (const char*)g.Bt + (size_t)nxt.pn * tsB : cB;
        for (int t = 0; t < nt; t += 2) {
            const bool last = (t == nt - 2);
            const char* a1 = cA + (size_t)(t + 1) * kstep;
            const char* a2 = last ? nA : cA + (size_t)(t + 2) * kstep; const char* b2 = last ? nB : cB + (size_t)(t + 2) * kstep;
            const char* a3 = a2 + kstep; const char* b3 = b2 + kstep;
            if constexpr (Mid::ON) { if (t * 2 == nt && t != 0) Md.apply(acc, cur, wr, fr, fq); }
            PG8_LDB(B0, 0, 0); PG8_LDB(B1, 0, 1); PG8_SCHED; PG8_LDA(At, 0, 0); PG8_STAGE(PG8_SA(1, 1), a1 + hsA, voffA);
            PG8_WAIT_V(8); PG8_WAIT_L(0); PG8_BAR; PG8_MMA(0, 0, At, B0); PG8_MMA(0, 1, At, B1); PG8_BAR; PG8_SCHED;
            PG8_LDA(At, 0, 1); PG8_STAGE(PG8_SB(0, 0), b2, voffB); PG8_STAGE(PG8_SB(0, 1), b2 + hsB, voffB); PG8_STAGE(PG8_SA(0, 0), a2, voffA);
            PG8_WAIT_V(8); PG8_WAIT_L(0); PG8_BAR; PG8_MMA(1, 0, At, B0); PG8_MMA(1, 1, At, B1); PG8_BAR; PG8_SCHED;
            PG8_LDB(B0, 1, 0); PG8_LDB(B1, 1, 1); PG8_SCHED; PG8_LDA(At, 1, 0); PG8_STAGE(PG8_SA(0, 1), a2 + hsA, voffA);
            PG8_WAIT_V(8); PG8_WAIT_L(0); PG8_BAR; PG8_MMA(0, 0, At, B0); PG8_MMA(0, 1, At, B1); PG8_BAR; PG8_SCHED;
            PG8_LDA(At, 1, 1); PG8_STAGE(PG8_SB(1, 0), b3, voffB); PG8_STAGE(PG8_SB(1, 1), b3 + hsB, voffB); PG8_STAGE(PG8_SA(1, 0), a3, voffA);
            PG8_WAIT_V(8); PG8_WAIT_L(0); PG8_BAR; PG8_MMA(1, 0, At, B0); PG8_MMA(1, 1, At, B1); PG8_BAR; PG8_SCHED;
        }
        if (wr == 0) PG8_BAR;
        E(acc, cur, wr, wc, fr, fq);
        if (!has_next) break;
#pragma unroll
        for (int a = 0; a < 2; ++a)
#pragma unroll
            for (int b = 0; b < 2; ++b)
#pragma unroll
                for (int m = 0; m < 4; ++m)
#pragma unroll
                    for (int n = 0; n < 2; ++n) acc[a][b][m][n] = (f32x4){0.f, 0.f, 0.f, 0.f};
        cur = nxt; cA = nA; cB = nB; ++ui;
        if (wr == 1) PG8_BAR;
    }
    PG8_WAIT_V(0);
    PG8_BAR;
#undef PG8_SA
#undef PG8_SB
#undef PG8_STAGE
#undef PG8_LDA
#undef PG8_LDB
#undef PG8_MMA
#undef PG8_WAIT_V
#undef PG8_WAIT_L
#undef PG8_BAR
#undef PG8_SCHED
}
}

typedef const f32x4 (&AccRef)[2][2][4][2];
constexpr int TAB_OFF = 131072, TABB_OFF = TAB_OFF + 4096;
__device__ __forceinline__ int tab_idx(int pm, int r) { return (((pm >> 3) & 3) << 8) | (r & 255); }
__device__ __forceinline__ float tabA(LAS unsigned char* lds, int pm, int r) { return *(const LAS float*)(lds + TAB_OFF + 4 * tab_idx(pm, r)); }
__device__ __forceinline__ float tabB(LAS unsigned char* lds, int pm, int r) { return *(const LAS float*)(lds + TABB_OFF + 4 * tab_idx(pm, r)); }
__device__ __forceinline__ int tab_row(int bx, int idx) { return (8 * (4 * (bx & 7) + (idx >> 8)) + ((bx >> 3) & 7)) * 256 + (idx & 255); }

__device__ __forceinline__ f32x4 silu_mul(f32x4 g, f32x4 u, float rstd) {
    const float c2 = -LOG2E * rstd, r2 = rstd * rstd; f32x4 o;
#pragma unroll
    for (int h = 0; h < 2; ++h) {
        const f32x2 gg = (f32x2){g[2 * h], g[2 * h + 1]}, uu = (f32x2){u[2 * h], u[2 * h + 1]};
        f32x2 ar = gg * c2; ar.x = fminf(ar.x, 60.f); ar.y = fminf(ar.y, 60.f);
        f32x2 e; e.x = __builtin_amdgcn_exp2f(ar.x); e.y = __builtin_amdgcn_exp2f(ar.y);
        const f32x2 d = e + 1.0f; const float rr = __builtin_amdgcn_rcpf(d.x * d.y);
        const f32x2 r = (f32x2){d.y, d.x} * rr;
        const f32x2 p = ((gg * uu) * r2) * r;
        o[2 * h] = p.x; o[2 * h + 1] = p.y;
    }
    return o;
}
__device__ __forceinline__ u32x4 pack8(f32x4 a, f32x4 b) { u32x4 w; w.x = cvt_pk_bf16(a[0], a[1]); w.y = cvt_pk_bf16(a[2], a[3]); w.z = cvt_pk_bf16(b[0], b[1]); w.w = cvt_pk_bf16(b[2], b[3]); return w; }
__device__ __forceinline__ f32x4 bf_lo4(u32x4 w) { return (f32x4){__builtin_bit_cast(float, w.x << 16), __builtin_bit_cast(float, w.x & 0xffff0000u), __builtin_bit_cast(float, w.y << 16), __builtin_bit_cast(float, w.y & 0xffff0000u)}; }
__device__ __forceinline__ f32x4 bf_hi4(u32x4 w) { return (f32x4){__builtin_bit_cast(float, w.z << 16), __builtin_bit_cast(float, w.z & 0xffff0000u), __builtin_bit_cast(float, w.w << 16), __builtin_bit_cast(float, w.w & 0xffff0000u)}; }
__device__ __forceinline__ void rot8(f32x4& v0, f32x4& v1, f32x4 t0, f32x4 t1) {
    const f32x4 a = v0, b = v1;
    v0[0] = a[0] * t0[0] - a[1] * t0[1]; v0[1] = a[1] * t0[0] + a[0] * t0[1]; v0[2] = a[2] * t0[2] - a[3] * t0[3]; v0[3] = a[3] * t0[2] + a[2] * t0[3];
    v1[0] = b[0] * t1[0] - b[1] * t1[1]; v1[1] = b[1] * t1[0] + b[0] * t1[1]; v1[2] = b[2] * t1[2] - b[3] * t1[3]; v1[3] = b[3] * t1[2] + b[2] * t1[3];
}

struct EpiSwiGLU {
    static constexpr bool PERM = true;
    bf16_t* O; LAS unsigned char* lds;
    __device__ __forceinline__ void operator()(AccRef acc, const pg8::Unit& u, int wr, int wc, int fr, int fq) const {
        const int row0 = u.pm * 256 + wr * 64 + fr, col0 = u.pn * 128 + wc * 32 + 8 * fq;
#pragma unroll
        for (int ai = 0; ai < 2; ++ai)
#pragma unroll
            for (int m = 0; m < 4; ++m) {
                const int r = row0 + ai * 128 + m * 16; const float rstd = tabA(lds, u.pm, r);
                const f32x4 v0 = silu_mul(acc[ai][0][m][0], acc[ai][1][m][0], rstd), v1 = silu_mul(acc[ai][0][m][1], acc[ai][1][m][1], rstd);
                __builtin_nontemporal_store(pack8(v0, v1), (u32x4*)(O + (size_t)r * DFF + col0));
            }
    }
};

template <bool USE_TAB>
struct EpiResid {
    static constexpr bool PERM = true;
    bf16_t* HBo; float* stats; float alpha; LAS unsigned char* lds;
    __device__ __forceinline__ void operator()(AccRef acc, const pg8::Unit& u, int wr, int wc, int fr, int fq) const {
        const int row0 = u.pm * 256 + wr * 64 + fr, c0 = u.pn * 256 + wc * 32 + 8 * fq;
        u32x4 bs[8][2];
#define RES_LOAD(it_) do { const u32x4* p = (const u32x4*)(HBo + (size_t)(row0 + ((it_) >> 2) * 128 + ((it_) & 3) * 16) * DM + c0); bs[it_][0] = p[0]; bs[it_][1] = p[16]; } while (0)
        RES_LOAD(0); RES_LOAD(1); RES_LOAD(2); RES_LOAD(3);
#pragma unroll
        for (int it = 0; it < 8; ++it) {
            if (it + 4 < 8) { RES_LOAD((it + 4) & 7); }
            const int ai = it >> 2, m = it & 3, r = row0 + ai * 128 + m * 16;
            const float sc = USE_TAB ? tabB(lds, u.pm, r) : alpha;
            float ss = 0.f;
#pragma unroll
            for (int bj = 0; bj < 2; ++bj) {
                const f32x4 v0 = bf_lo4(bs[it][bj]) + acc[ai][bj][m][0] * sc, v1 = bf_hi4(bs[it][bj]) + acc[ai][bj][m][1] * sc;
                ss += sq4(v0) + sq4(v1);
                *(u32x4*)(HBo + (size_t)r * DM + c0 + bj * 128) = pack8(v0, v1);
            }
            ss = quad_sum(ss);
            if (fq == 0) stats[(size_t)r * 16 + u.pn * 4 + wc] = ss;
        }
#undef RES_LOAD
    }
};
struct EpiFinal {
    static constexpr bool PERM = true;
    const bf16_t* HBi; float* stats; float* out; const float* gfin; unsigned* pcnt; float alpha;
    __device__ __forceinline__ void operator()(AccRef acc, const pg8::Unit& u, int wr, int wc, int fr, int fq) const {
        const int row0 = u.pm * 256 + wr * 64 + fr, c0 = u.pn * 256 + wc * 32 + 8 * fq;
        f32x4 v[8][2][2];
        u32x4 bs[8][2];
#define FIN_LOAD(it_) do { const u32x4* p = (const u32x4*)(HBi + (size_t)(row0 + ((it_) >> 2) * 128 + ((it_) & 3) * 16) * DM + c0); bs[it_][0] = p[0]; bs[it_][1] = p[16]; } while (0)
        FIN_LOAD(0); FIN_LOAD(1); FIN_LOAD(2); FIN_LOAD(3);
#pragma unroll
        for (int it = 0; it < 8; ++it) {
            if (it + 4 < 8) { FIN_LOAD((it + 4) & 7); }
            const int ai = it >> 2, m = it & 3, r = row0 + ai * 128 + m * 16;
            float ss = 0.f;
#pragma unroll
            for (int bj = 0; bj < 2; ++bj) {
                v[it][bj][0] = bf_lo4(bs[it][bj]) + acc[ai][bj][m][0] * alpha; v[it][bj][1] = bf_hi4(bs[it][bj]) + acc[ai][bj][m][1] * alpha;
                ss += sq4(v[it][bj][0]) + sq4(v[it][bj][1]);
            }
            ss = quad_sum(ss);
            if (fq == 0) __hip_atomic_store(stats + (size_t)r * 16 + u.pn * 4 + wc, ss, __ATOMIC_RELAXED, __HIP_MEMORY_SCOPE_AGENT);
        }
#undef FIN_LOAD
        asm volatile("s_waitcnt vmcnt(0)" ::: "memory");
        __builtin_amdgcn_s_barrier();
        if (threadIdx.x == 0) {
            unsigned* c = pcnt + 16 * u.pm;
            __hip_atomic_fetch_add(c, 1u, __ATOMIC_RELAXED, __HIP_MEMORY_SCOPE_AGENT);
            unsigned spins = 0;
            while (__hip_atomic_load(c, __ATOMIC_RELAXED, __HIP_MEMORY_SCOPE_AGENT) < 4u) { __builtin_amdgcn_s_sleep(1); if (++spins > (1u << 22)) break; }
            __builtin_amdgcn_fence(__ATOMIC_ACQUIRE, "agent");
            asm volatile("s_waitcnt vmcnt(0)" ::: "memory");
        }
        __builtin_amdgcn_s_barrier();
        asm volatile("" ::: "memory");
        f32x4 gf[2][2];
#pragma unroll
        for (int bj = 0; bj < 2; ++bj) { gf[bj][0] = *(const f32x4*)(gfin + c0 + bj * 128); gf[bj][1] = *(const f32x4*)(gfin + c0 + bj * 128 + 4); }
#pragma unroll
        for (int it = 0; it < 8; ++it) {
            const int r = row0 + (it >> 2) * 128 + (it & 3) * 16;
            const float* sp = stats + (size_t)r * 16 + 4 * fq;
            f32x4 st; st.x = __hip_atomic_load(sp, __ATOMIC_RELAXED, __HIP_MEMORY_SCOPE_AGENT); st.y = __hip_atomic_load(sp + 1, __ATOMIC_RELAXED, __HIP_MEMORY_SCOPE_AGENT);
            st.z = __hip_atomic_load(sp + 2, __ATOMIC_RELAXED, __HIP_MEMORY_SCOPE_AGENT); st.w = __hip_atomic_load(sp + 3, __ATOMIC_RELAXED, __HIP_MEMORY_SCOPE_AGENT);
            const float rstd = 1.0f / sqrtf(quad_sum(sum4(st)) * (1.0f / DM) + EPS);
#pragma unroll
            for (int bj = 0; bj < 2; ++bj) { float* op = out + (size_t)r * DM + c0 + bj * 128;
                __builtin_nontemporal_store(v[it][bj][0] * rstd * gf[bj][0], (f32x4*)op); __builtin_nontemporal_store(v[it][bj][1] * rstd * gf[bj][1], (f32x4*)(op + 4)); }
        }
    }
};
struct MidWo {
    static constexpr bool ON = true;
    LAS unsigned char* lds;
    __device__ __forceinline__ void apply(f32x4 (&acc)[2][2][4][2], const pg8::Unit& u, int wr, int fr, int fq) const {
        const int row0 = u.pm * 256 + wr * 64 + fr;
#pragma unroll
        for (int ai = 0; ai < 2; ++ai)
#pragma unroll
            for (int m = 0; m < 4; ++m) {
                const float ratio = tabA(lds, u.pm, row0 + ai * 128 + m * 16);
#pragma unroll
                for (int bj = 0; bj < 2; ++bj)
#pragma unroll
                    for (int n = 0; n < 2; ++n) acc[ai][bj][m][n] = acc[ai][bj][m][n] * ratio;
            }
    }
};
struct EpiProj {
    static constexpr bool PERM = true;
    bf16_t* P; float* pq; float* pkv; const f32x2* rope; LAS unsigned char* lds;
    __device__ __forceinline__ void operator()(AccRef acc, const pg8::Unit& u, int wr, int wc, int fr, int fq) const {
        const int row0 = u.pm * 256 + wr * 64 + fr, col0 = u.pn * 256 + wc * 32 + 8 * fq;
        const bool is0 = (u.pn == 0), is1 = (u.pn == 1), dorope = is1 && (wc == 0);
#pragma unroll
        for (int ai = 0; ai < 2; ++ai)
#pragma unroll
            for (int m = 0; m < 4; ++m) {
                const int r = row0 + ai * 128 + m * 16; const float rstd = tabA(lds, u.pm, r);
                f32x4 v00 = acc[ai][0][m][0] * rstd, v01 = acc[ai][0][m][1] * rstd, v10 = acc[ai][1][m][0] * rstd, v11 = acc[ai][1][m][1] * rstd;
                if (is0 | is1) { float ss = sq4(v00) + sq4(v01); if (is0) ss += sq4(v10) + sq4(v11); ss = quad_sum(ss); if (fq == 0) (is0 ? pq : pkv)[(size_t)r * 4 + wc] = ss; }
                {
                    f32x4 t0 = (f32x4){1.f, 0.f, 1.f, 0.f}, t1 = t0;
                    if (dorope) { const f32x4* tp = (const f32x4*)(rope + (size_t)(r & (SEQ - 1)) * 16 + 4 * fq); t0 = tp[0]; t1 = tp[1]; }
                    rot8(v10, v11, t0, t1);
                }
                *(u32x4*)(P + (size_t)r * NPROJ + col0) = pack8(v00, v01);
                *(u32x4*)(P + (size_t)r * NPROJ + col0 + 128) = pack8(v10, v11);
            }
    }
};
struct EpiQ {
    static constexpr bool PERM = true;
    bf16_t* Q; const f32x2* rope; LAS unsigned char* lds;
    __device__ __forceinline__ void operator()(AccRef acc, const pg8::Unit& u, int wr, int wc, int fr, int fq) const {
        const int row0 = u.pm * 256 + wr * 64 + fr, col0 = u.pn * 256 + wc * 32 + 8 * fq;
#pragma unroll
        for (int ai = 0; ai < 2; ++ai)
#pragma unroll
            for (int m = 0; m < 4; ++m) {
                const int r = row0 + ai * 128 + m * 16; const float rstd = tabA(lds, u.pm, r);
#pragma unroll
                for (int bj = 0; bj < 2; ++bj) { const int c0 = col0 + bj * 128, w = c0 % 96;
                    f32x4 v0 = acc[ai][bj][m][0] * rstd, v1 = acc[ai][bj][m][1] * rstd;
                    f32x4 t0 = (f32x4){1.f, 0.f, 1.f, 0.f}, t1 = t0;
                    if (w >= 64) { const f32x4* tp = (const f32x4*)(rope + (size_t)(r & (SEQ - 1)) * 16 + ((w - 64) >> 1)); t0 = tp[0]; t1 = tp[1]; }
                    rot8(v0, v1, t0, t1);
                    *(u32x4*)(Q + (size_t)r * NQ + c0) = pack8(v0, v1); }
            }
    }
};
struct EpiKV {
    static constexpr bool PERM = true;
    bf16_t* KV; LAS unsigned char* lds;
    __device__ __forceinline__ void operator()(AccRef acc, const pg8::Unit& u, int wr, int wc, int fr, int fq) const {
        const int row0 = u.pm * 256 + wr * 64 + fr, col0 = u.pn * 256 + wc * 32 + 8 * fq;
#pragma unroll
        for (int ai = 0; ai < 2; ++ai)
#pragma unroll
            for (int m = 0; m < 4; ++m) {
                const int r = row0 + ai * 128 + m * 16; const float rstd = tabB(lds, u.pm, r);
#pragma unroll
                for (int bj = 0; bj < 2; ++bj)
                    *(u32x4*)(KV + (size_t)r * NKV + col0 + bj * 128) = pack8(acc[ai][bj][m][0] * rstd, acc[ai][bj][m][1] * rstd);
            }
    }
};

struct AttnT { const bf16_t* qmla; const bf16_t* kv; const bf16_t* proj; bf16_t* o; float* po; const float* bias; const float* sinks; };

template <bool SWA>
__device__ __forceinline__ void attn_unit(LAS unsigned char* lds, int b, int h, int qb, const AttnT& T, bool have) {
    constexpr int DQK = SWA ? 64 : 96, NS = DQK / 32, KP = DQK * 2 + 16, VP = 160;
    constexpr int KBUF = 16384, VOFF = 32768, VBUF = 16384, BIASOFF = 65536;
    const int tid = threadIdx.x, lane = tid & 63, wid = __builtin_amdgcn_readfirstlane(tid >> 6), l15 = lane & 15, g = lane >> 4;
    const int Q0 = SWA ? qb * 64 : qb * 256, q0w = SWA ? Q0 + 32 * (wid & 1) : Q0 + 32 * wid, hw = SWA ? 4 * h + (wid >> 1) : h;
    const size_t tok0 = (size_t)b * SEQ;
    bf16x8 Qf[2][NS];
#pragma unroll
    for (int sb = 0; sb < 2; ++sb)
#pragma unroll
        for (int s = 0; s < NS; ++s) {
            const size_t row = tok0 + q0w + 16 * sb + l15;
            const bf16_t* p = SWA ? T.proj + row * NPROJ + PC_QS + 64 * hw + 32 * s + 8 * g : T.qmla + row * NQ + 96 * h + 32 * s + 8 * g;
            Qf[sb][s] = *(const bf16x8*)p;
        }
    f32x4 negm[2], lacc[2], oT[2][4];
    const bf16x8 ones = (bf16x8){0x3F80, 0x3F80, 0x3F80, 0x3F80, 0x3F80, 0x3F80, 0x3F80, 0x3F80};
#pragma unroll
    for (int sb = 0; sb < 2; ++sb) {
        if (SWA) { const float ms = -T.sinks[hw] * LOG2E; negm[sb] = (f32x4){ms, ms, ms, ms}; lacc[sb] = (f32x4){1.f, 1.f, 1.f, 1.f}; } else { negm[sb] = (f32x4){0.f, 0.f, 0.f, 0.f}; lacc[sb] = negm[sb]; }
#pragma unroll
        for (int c = 0; c < 4; ++c) oT[sb][c] = (f32x4){0.f, 0.f, 0.f, 0.f};
    }
    const int kbase = SWA ? Q0 - 128 : 0, j0 = SWA ? (Q0 < 128 ? (128 - Q0) / 64 : 0) : 0, NT = SWA ? 3 : 4 * (qb + 1);
    const int skey = tid >> 3, sch = tid & 7;
    const bf16_t* ksrc; const bf16_t* vsrc; const bf16_t* pesrc = nullptr; size_t kpitch;
    if (SWA) { const int kvh = h; ksrc = T.proj + (tok0 + skey) * NPROJ + PC_KS + 64 * kvh + 8 * sch; vsrc = ksrc + (PC_VS - PC_KS); kpitch = NPROJ; }
    else { ksrc = T.kv + (tok0 + skey) * NKV + 128 * h + 8 * sch; vsrc = ksrc + 64; kpitch = NKV; pesrc = T.proj + (tok0 + (tid >> 2)) * NPROJ + PC_KPE + 8 * (tid & 3); }
    const int kdst = skey * KP + 16 * sch, vdst = VOFF + skey * VP + 16 * sch, pedst = (tid >> 2) * KP + 128 + 16 * (tid & 3);
    if (SWA && !have) { for (int e = tid; e < 4 * 320; e += 512) { const int hl = e / 320, x = e % 320, d = 223 - x;
            *(LAS float*)(lds + BIASOFF + 4 * e) = ((unsigned)d < 128u) ? T.bias[(4 * h + hl) * 128 + d] : -1e30f; } }
    u32x4 rk, rv, rpe = (u32x4){0u, 0u, 0u, 0u};
#define AT_LOAD(j) do { const size_t k0_ = (size_t)(kbase + 64 * (j)); rk = *(const u32x4*)(ksrc + k0_ * kpitch); rv = *(const u32x4*)(vsrc + k0_ * kpitch); \
        if (!SWA) { if (tid < 256) rpe = *(const u32x4*)(pesrc + k0_ * NPROJ); } } while (0)
#define AT_STORE(bi) do { *(LAS u32x4*)(lds + (bi) * KBUF + kdst) = rk; *(LAS u32x4*)(lds + (bi) * VBUF + vdst) = rv; \
        if (!SWA) { if (tid < 256) *(LAS u32x4*)(lds + (bi) * KBUF + pedst) = rpe; } } while (0)
    AT_LOAD(j0); AT_STORE(0);
    if (j0 + 1 < NT) AT_LOAD(j0 + 1);
    __syncthreads();
    for (int j = j0; j < NT; ++j) {
        const bool more = j + 1 < NT; const int bi = (j - j0) & 1; const int k0 = kbase + 64 * j;
        if (more) AT_STORE(bi ^ 1);
        if (j + 2 < NT) AT_LOAD(j + 2);
        const bool active = SWA ? (k0 + 63 >= q0w - 127 && k0 <= q0w + 31) : (k0 <= q0w + 31);
        if (active) {
            const LAS unsigned char* Kb = lds + bi * KBUF; const LAS unsigned char* Vb = lds + VOFF + bi * VBUF;
            f32x4 sT[2][4];
#pragma unroll
            for (int kb = 0; kb < 4; ++kb) {
                const int rowk = 16 * kb + l15;
                sT[0][kb] = negm[0]; sT[1][kb] = negm[1];
#pragma unroll
                for (int s = 0; s < NS; ++s) {
                    const bf16x8 Kf = *(const LAS bf16x8*)(Kb + rowk * KP + (32 * s + 8 * g) * 2);
                    sT[0][kb] = __builtin_amdgcn_mfma_f32_16x16x32_bf16(Kf, Qf[0][s], sT[0][kb], 0, 0, 0);
                    sT[1][kb] = __builtin_amdgcn_mfma_f32_16x16x32_bf16(Kf, Qf[1][s], sT[1][kb], 0, 0, 0);
                }
            }
            const bool need_mask = SWA ? true : (k0 + 63 > q0w);
            u32x4 pw[2][2];
#pragma unroll
            for (int sb = 0; sb < 2; ++sb) {
                const int q = q0w + 16 * sb + l15;
                if (SWA) {
                    const LAS float* bt = (const LAS float*)(lds + BIASOFF) + (wid >> 1) * 320 + (223 - q + k0 + 4 * g);
#pragma unroll
                    for (int kb = 0; kb < 4; ++kb)
#pragma unroll
                        for (int i = 0; i < 4; ++i) sT[sb][kb][i] += bt[16 * kb + i];
                } else if (need_mask) {
#pragma unroll
                    for (int kb = 0; kb < 4; ++kb)
#pragma unroll
                        for (int i = 0; i < 4; ++i) { const int key = k0 + 16 * kb + 4 * g + i; if (key > q) sT[sb][kb][i] = -1e30f; }
                }
                const bool first = (!SWA) && (j == 0);
                if (first || (SWA ? (j == j0) : ((j & 7) == 0))) {
                float mx = fmaxf(fmaxf(sT[sb][0][0], sT[sb][0][1]), sT[sb][0][2]);
                mx = fmaxf(fmaxf(mx, sT[sb][0][3]), sT[sb][1][0]); mx = fmaxf(fmaxf(mx, sT[sb][1][1]), sT[sb][1][2]); mx = fmaxf(fmaxf(mx, sT[sb][1][3]), sT[sb][2][0]);
                mx = fmaxf(fmaxf(mx, sT[sb][2][1]), sT[sb][2][2]); mx = fmaxf(fmaxf(mx, sT[sb][2][3]), sT[sb][3][0]); mx = fmaxf(fmaxf(mx, sT[sb][3][1]), sT[sb][3][2]);
                mx = fmaxf(mx, sT[sb][3][3]);
                mx = quad_max(mx);
                if (first || __any(mx > 6.f)) {
                    const float delta = first ? mx : fmaxf(mx, 0.f); negm[sb] = negm[sb] - delta;
                    if (!first) { const float alpha = __builtin_amdgcn_exp2f(-delta); lacc[sb] = lacc[sb] * alpha;
#pragma unroll
                        for (int c = 0; c < 4; ++c) oT[sb][c] = oT[sb][c] * alpha; }
#pragma unroll
                    for (int kb = 0; kb < 4; ++kb) sT[sb][kb] = sT[sb][kb] - delta;
                }
                }
#pragma unroll
                for (int kb = 0; kb < 4; ++kb)
#pragma unroll
                    for (int i = 0; i < 4; ++i) sT[sb][kb][i] = __builtin_amdgcn_exp2f(sT[sb][kb][i]);
#pragma unroll
                for (int ks = 0; ks < 2; ++ks) pw[sb][ks] = pack8(sT[sb][2 * ks], sT[sb][2 * ks + 1]);
            }
#pragma unroll
            for (int ks = 0; ks < 2; ++ks) {
                const bf16x8 P0 = __builtin_bit_cast(bf16x8, pw[0][ks]), P1 = __builtin_bit_cast(bf16x8, pw[1][ks]);
                lacc[0] = __builtin_amdgcn_mfma_f32_16x16x32_bf16(ones, P0, lacc[0], 0, 0, 0); lacc[1] = __builtin_amdgcn_mfma_f32_16x16x32_bf16(ones, P1, lacc[1], 0, 0, 0);
#pragma unroll
                for (int c = 0; c < 4; ++c) {
                    const LAS unsigned char* ta = Vb + (32 * ks + 4 * g + (l15 >> 2)) * VP + (16 * c + 4 * (lane & 3)) * 2;
                    const s16x4 lo = __builtin_amdgcn_ds_read_tr16_b64_v4i16((LAS s16x4*)ta);
                    const s16x4 hi = __builtin_amdgcn_ds_read_tr16_b64_v4i16((LAS s16x4*)(ta + 16 * VP));
                    const bf16x8 Vf = (bf16x8){lo[0], lo[1], lo[2], lo[3], hi[0], hi[1], hi[2], hi[3]};
                    oT[0][c] = __builtin_amdgcn_mfma_f32_16x16x32_bf16(Vf, P0, oT[0][c], 0, 0, 0);
                    oT[1][c] = __builtin_amdgcn_mfma_f32_16x16x32_bf16(Vf, P1, oT[1][c], 0, 0, 0);
                }
            }
        }
        asm volatile("s_waitcnt lgkmcnt(0)" ::: "memory");
        __builtin_amdgcn_s_barrier();
        asm volatile("" ::: "memory");
    }
#undef AT_LOAD
#undef AT_STORE
#pragma unroll
    for (int sb = 0; sb < 2; ++sb) {
        const float inv = 1.0f / lacc[sb][0];
        const size_t row = tok0 + q0w + 16 * sb + l15; float ss = 0.f;
#pragma unroll
        for (int c = 0; c < 4; ++c) { f32x4 v = oT[sb][c] * inv;
#if defined(DBG_ZERO_SWA)
            if (SWA) v = (f32x4){0.f, 0.f, 0.f, 0.f};
#endif
#if defined(DBG_ZERO_MLA)
            if (!SWA) v = (f32x4){0.f, 0.f, 0.f, 0.f};
#endif
            ss += sq4(v); u32x2 w; w.x = cvt_pk_bf16(v[0], v[1]); w.y = cvt_pk_bf16(v[2], v[3]);
            *(u32x2*)(T.o + row * DM + (SWA ? 512 : 0) + 64 * hw + 16 * c + 4 * g) = w; }
        ss = quad_sum(ss);
        if (g == 0) T.po[row * 16 + (SWA ? 8 : 0) + hw] = ss;
    }
}


#if defined(DBG_NAIVE_SWA)
__device__ __forceinline__ float bf2f(bf16_t v) { return __builtin_bit_cast(float, (unsigned)v << 16); }
__device__ __forceinline__ void naive_swa(const AttnT& T, int gt, int NGT) {
    for (int idx = gt; idx < MTOK * 8; idx += NGT) {
        const int t = idx >> 3, hq = idx & 7, s = t & (SEQ - 1), kvh = hq >> 2;
        float q[64], o[64];
#pragma unroll
        for (int d = 0; d < 64; ++d) { q[d] = bf2f(T.proj[(size_t)t * NPROJ + PC_QS + 64 * hq + d]); o[d] = 0.f; }
        float m = T.sinks[hq] * LOG2E, l = 1.f;
        const int klo = s - 127 < 0 ? 0 : s - 127;
        for (int k = klo; k <= s; ++k) {
            const size_t kr = (size_t)(t - s + k) * NPROJ;
            float sc = 0.f;
#pragma unroll
            for (int d = 0; d < 64; ++d) sc += q[d] * bf2f(T.proj[kr + PC_KS + 64 * kvh + d]);
            sc += T.bias[hq * 128 + (s - k)];
            const float mn = fmaxf(m, sc), al = exp2f(m - mn), p = exp2f(sc - mn); m = mn; l = l * al + p;
#pragma unroll
            for (int d = 0; d < 64; ++d) o[d] = o[d] * al + p * bf2f(T.proj[kr + PC_VS + 64 * kvh + d]);
        }
        float ss = 0.f; const float inv = 1.f / l;
#pragma unroll
        for (int d = 0; d < 64; d += 2) { const float a = o[d] * inv, b = o[d + 1] * inv; ss += a * a + b * b; *(unsigned*)(T.o + (size_t)t * DM + 512 + 64 * hq + d) = cvt_pk_bf16(a, b); }
        T.po[(size_t)t * 16 + 8 + hq] = ss;
    }
}
#endif


#if defined(DBG_NAIVE_PROJ)
__device__ __forceinline__ float bf2f_(bf16_t v) { return __builtin_bit_cast(float, (unsigned)v << 16); }
__device__ __forceinline__ void naive_proj_swa(const bf16_t* HB, const float* stats, const float* gmix, const float* win, bf16_t* proj, int gt, int NGT) {
    for (int idx = gt; idx < MTOK * 768; idx += NGT) {
        const int t = idx / 768, j = idx % 768, n = 416 + j;
        float ssum = 0.f;
        for (int i = 0; i < 16; ++i) ssum += stats[(size_t)t * 16 + i];
        const float rstd = 1.0f / sqrtf(ssum * (1.0f / DM) + EPS);
        float acc = 0.f;
        for (int k = 0; k < DM; ++k) acc += bf2f_(HB[(size_t)t * DM + k]) * (gmix[k] * win[(size_t)k * 1184 + n]);
        const float val = acc * rstd * (j < 512 ? 0.125f * LOG2E : 1.0f);
        const int dest = j < 512 ? PC_QS + j : (j < 640 ? PC_KS + (j - 512) : PC_VS + (j - 640));
        proj[(size_t)t * NPROJ + dest] = (bf16_t)(cvt_pk_bf16(val, 0.f) & 0xffffu);
    }
}
#endif

#define RLX_AGENT __ATOMIC_RELAXED, __HIP_MEMORY_SCOPE_AGENT
#define XB_TMO      128
#define XB_XCNT(j)  (256  + 64 * (j))
#define XB_XSUB(j)  (1280 + 64 * (j))
#define XB_XGEN(j)  (2304 + 64 * (j))
#define XB_TOP      3328
#define XB_TOPGEN   3392
#define XCD_BAR_WORDS 3456
#define XB_SPIN_CAP (1u << 18)

__device__ __forceinline__ unsigned xb_ld(unsigned* p)              { return __hip_atomic_load(p, __ATOMIC_RELAXED, __HIP_MEMORY_SCOPE_AGENT); }
__device__ __forceinline__ unsigned xb_add(unsigned* p, unsigned v) { return __hip_atomic_fetch_add(p, v, __ATOMIC_RELAXED, __HIP_MEMORY_SCOPE_AGENT); }
__device__ __forceinline__ unsigned xb_xcc_id() { return (unsigned)__builtin_amdgcn_s_getreg((3 << 11) | 20) & 0xFu; }
#define XB_SPIN(cond, bar) do { unsigned _sp = 0; while (cond) { __builtin_amdgcn_s_sleep(1); \
    if ((++_sp & 255u) == 0u) { if (xb_ld(&(bar)[XB_TMO])) break; if (_sp > XB_SPIN_CAP) { atomicAdd(&(bar)[XB_TMO], 1u); break; } } } } while (0)

struct XcdBarrier {
    unsigned* bar; unsigned x;
    volatile LAS unsigned* st;
};

__device__ __forceinline__ XcdBarrier xcd_barrier_post(unsigned* bar, volatile LAS unsigned* st) {
    XcdBarrier b; b.bar = bar; b.x = xb_xcc_id(); b.st = st;
    if (threadIdx.x == 0) (void)xb_add(&bar[XB_XCNT(b.x)], 1u);
    return b;
}
__device__ __forceinline__ void xcd_barrier_complete(unsigned* bar, unsigned x, unsigned& nloc, unsigned& nx) {
    const unsigned G = gridDim.x * gridDim.y * gridDim.z;
    unsigned sum, cnt, mine, sp = 0u;
    for (;;) {
        sum = 0u; cnt = 0u; mine = 0u;
#pragma unroll
        for (unsigned j = 0; j < 16; ++j) { const unsigned c = xb_ld(&bar[XB_XCNT(j)]); sum += c; cnt += (c > 0u) ? 1u : 0u; mine = (j == x) ? c : mine; }
        if (sum == G) break;
        __builtin_amdgcn_s_sleep(1);
        if ((++sp & 255u) == 0u) { if (xb_ld(&bar[XB_TMO])) break; if (sp > XB_SPIN_CAP) { atomicAdd(&bar[XB_TMO], 1u); break; } }
    }
    nloc = mine > 0u ? mine : 1u; nx = cnt > 0u ? cnt : 1u;
}

__device__ __forceinline__ void xcd_barrier(const XcdBarrier& b) {
    asm volatile("s_waitcnt vmcnt(0)" ::: "memory");
    __syncthreads();
    if (threadIdx.x == 0) {
        unsigned* bar = b.bar;
        __builtin_amdgcn_s_waitcnt(0);
        unsigned nloc = b.st[0], nx = b.st[1];
        if (nloc == 0u) { xcd_barrier_complete(bar, b.x, nloc, nx); b.st[0] = nloc; b.st[1] = nx; }
        const unsigned old = xb_add(&bar[XB_XSUB(b.x)], 1u);
        const unsigned gen = old / nloc;
        if (old + 1u == (gen + 1u) * nloc) {
            __builtin_amdgcn_fence(__ATOMIC_RELEASE, "agent");
            asm volatile("s_waitcnt vmcnt(0)" ::: "memory");
            const unsigned og = xb_add(&bar[XB_TOP], 1u);
            const unsigned tg = og / nx;
            if (og + 1u == (tg + 1u) * nx) xb_add(&bar[XB_TOPGEN], 1u);
            else XB_SPIN(xb_ld(&bar[XB_TOPGEN]) == tg, bar);
            __builtin_amdgcn_fence(__ATOMIC_ACQUIRE, "agent");
            xb_add(&bar[XB_XGEN(b.x)], 1u);
            asm volatile("s_waitcnt vmcnt(0)" ::: "memory");
        } else {
            XB_SPIN(xb_ld(&bar[XB_XGEN(b.x)]) == gen, bar);
            __builtin_amdgcn_fence(__ATOMIC_ACQUIRE, "agent");
            asm volatile("s_waitcnt vmcnt(0)" ::: "memory");
        }
    }
    __syncthreads();
}

__device__ __forceinline__ unsigned f2bf(float f) { unsigned u = __builtin_bit_cast(unsigned, f); return (u + 0x7fffu + ((u >> 16) & 1u)) >> 16; }
__device__ __forceinline__ unsigned pk2(float lo, float hi) { return cvt_pk_bf16(lo, hi); }
enum MatId { ID_GATE = 0, ID_UP, ID_PLAIN, ID_IN, ID_QB };
__device__ __forceinline__ int rope_il(int i) { return i < 16 ? 2 * i : 2 * (i - 16) + 1; }
__device__ __forceinline__ void map_dest(int id, int n, int& row, float& sc) {
    sc = 1.f;
    if (id == ID_GATE) row = 256 * (n >> 7) + (n & 127);
    else if (id == ID_UP) row = 256 * (n >> 7) + 128 + (n & 127);
    else if (id == ID_IN) {
        if (n < 384) row = n;
        else if (n < 416) row = PC_KPE + rope_il(n - 384);
        else if (n < 928) { row = n - 416 + PC_QS; sc = 0.125f * LOG2E; }
        else if (n < 1056) row = n - 928 + PC_KS;
        else row = n - 1056 + PC_VS;
    } else if (id == ID_QB) { const int hh = n / 96, w = n % 96; row = (w < 64) ? n : 96 * hh + 64 + rope_il(w - 64); }
    else row = n;
}
struct P0Item { const float* W; int K, N; bf16_t* WT; int id; const float* ks; const float* ks2; int ksplit; int item; };
__device__ __forceinline__ void p0_item_load(const P0Item& d, float (&r)[32], int lane) {
    const int nblk = d.N / 32, kb = d.item / nblk, nb = d.item % nblk, k0 = 64 * kb, n0 = 32 * nb;
#pragma unroll
    for (int i = 0; i < 32; ++i) { const int kg = k0 + 2 * i + (lane >> 5); r[i] = d.W[(size_t)kg * d.N + n0 + (lane & 31)]; }
}
__device__ __forceinline__ void p0_item_finish(const P0Item& d, const float (&r)[32], LAS float* scr, int lane) {
    const int nblk = d.N / 32, kb = d.item / nblk, nb = d.item % nblk, k0 = 64 * kb, n0 = 32 * nb;
#pragma unroll
    for (int i = 0; i < 32; ++i) { const int kk = 2 * i + (lane >> 5), kg = k0 + kk; float v = r[i];
        if (d.ks) v *= (kg < d.ksplit) ? d.ks[kg] : d.ks2[kg - d.ksplit];
        scr[kk * 33 + (lane & 31)] = v; }
    asm volatile("s_waitcnt lgkmcnt(0)" ::: "memory");
    const int c = lane & 7;
#pragma unroll
    for (int j = 0; j < 4; ++j) { const int n = (lane >> 3) + 8 * j; const LAS float* sp = scr + (8 * c) * 33 + n; int drow; float sc; map_dest(d.id, n0 + n, drow, sc);
        u32x4 o; o.x = pk2(sp[0 * 33] * sc, sp[1 * 33] * sc); o.y = pk2(sp[2 * 33] * sc, sp[3 * 33] * sc); o.z = pk2(sp[4 * 33] * sc, sp[5 * 33] * sc); o.w = pk2(sp[6 * 33] * sc, sp[7 * 33] * sc);
        *(u32x4*)(d.WT + (size_t)drow * d.K + k0 + 8 * c) = o; }
    asm volatile("s_waitcnt lgkmcnt(0)" ::: "memory");
}
__device__ __forceinline__ void sincos_acc(float angf, float& c, float& s) {
    const double a = (double)angf; const double kq = rint(a * 0.63661977236758134); const double r = a - kq * 1.5707963267948966; const int q = ((int)kq) & 3; const double r2 = r * r;
    const double sp = r * (1.0 + r2 * (-1.0 / 6 + r2 * (1.0 / 120 + r2 * (-1.0 / 5040 + r2 * (1.0 / 362880 + r2 * (-1.0 / 39916800 + r2 * (1.0 / 6227020800.0)))))));
    const double cp = 1.0 + r2 * (-0.5 + r2 * (1.0 / 24 + r2 * (-1.0 / 720 + r2 * (1.0 / 40320 + r2 * (-1.0 / 3628800 + r2 * (1.0 / 479001600.0))))));
    const double sv = (q == 0) ? sp : (q == 1) ? cp : (q == 2) ? -sp : -cp, cv = (q == 0) ? cp : (q == 1) ? -sp : (q == 2) ? -cp : sp;
    c = (float)cv; s = (float)sv;
}

struct Args { const float* in[21]; float* out; unsigned char* ws; int ph_lo, ph_hi; };
constexpr int NPHASE = 9;

__global__ void __launch_bounds__(512, 2) mk_fwd(Args a) {
    extern __shared__ __attribute__((aligned(16))) unsigned char lds_raw[];
    LAS unsigned char* lds = (LAS unsigned char*)lds_raw;
    cg::grid_group grid = cg::this_grid();
    const int tid = threadIdx.x, lane = tid & 63, wave = __builtin_amdgcn_readfirstlane(tid >> 6);
    const int G = gridDim.x, bx = blockIdx.x;
    unsigned char* ws = a.ws;
    const float* x = a.in[0];
    f32x2* rope = (f32x2*)(ws + WS_ROPE); float* biasT = (float*)(ws + WS_BIAS);
    float* stats = (float*)(ws + WS_STATS); float* pq = (float*)(ws + WS_PQ); float* pkv = (float*)(ws + WS_PKV); float* po = (float*)(ws + WS_PO);
    bf16_t *W1gu = (bf16_t*)(ws + WS_W1GU), *W1d = (bf16_t*)(ws + WS_W1D), *W2gu = (bf16_t*)(ws + WS_W2GU), *W2d = (bf16_t*)(ws + WS_W2D);
    bf16_t *Win = (bf16_t*)(ws + WS_WIN), *Wqb = (bf16_t*)(ws + WS_WQB), *Wkvb = (bf16_t*)(ws + WS_WKVB), *Wo = (bf16_t*)(ws + WS_WO);
    bf16_t *hid = (bf16_t*)(ws + WS_HID), *proj = (bf16_t*)(ws + WS_PROJ), *qmla = (bf16_t*)(ws + WS_QMLA), *kvb = (bf16_t*)(ws + WS_KV), *ob = (bf16_t*)(ws + WS_O), *HB = (bf16_t*)(ws + WS_HB);
    const int lo = a.ph_lo, hi = a.ph_hi;
    volatile LAS unsigned* bst = (volatile LAS unsigned*)(lds + 139264);
    if (tid < 2) bst[tid] = 0u;
    __syncthreads();
    XcdBarrier xbar = xcd_barrier_post((unsigned*)(ws + WS_BAR), bst);
#ifndef PH_MASK
#define PH_MASK 0x3ff
#endif
#define IN(k) (((PH_MASK >> (k)) & 1) && lo <= (k) && (k) < hi)
#define SEAM(k) do { if (IN(k) && IN((k) + 1)) { if ((k) == 0) grid.sync(); else xcd_barrier(xbar); } } while (0)

    if (IN(0)) {
        LAS float* scr = (LAS float*)(lds + wave * 16384);
        const int gw = bx * 8 + wave, NGW = G * 8;
        constexpr int I_GU = (DM / 64) * (DFF / 32), I_D = (DFF / 64) * (DM / 32), I_IN = (DM / 64) * (1184 / 32), I_QB = (256 / 64) * (NQ / 32), I_KVB = (128 / 64) * (NKV / 32), I_O = (DM / 64) * (DM / 32);
        constexpr int NITEMS = 4 * I_GU + 2 * I_D + I_IN + I_QB + I_KVB + I_O;
#define P0_DECODE(it_, d_) do { int r = (it_); \
            if (r < I_GU) { d_ = P0Item{a.in[2], DM, DFF, W1gu, ID_GATE, a.in[1], a.in[1], DM, r}; break; } r -= I_GU; \
            if (r < I_GU) { d_ = P0Item{a.in[3], DM, DFF, W1gu, ID_UP, a.in[1], a.in[1], DM, r}; break; } r -= I_GU; \
            if (r < I_GU) { d_ = P0Item{a.in[17], DM, DFF, W2gu, ID_GATE, a.in[16], a.in[16], DM, r}; break; } r -= I_GU; \
            if (r < I_GU) { d_ = P0Item{a.in[18], DM, DFF, W2gu, ID_UP, a.in[16], a.in[16], DM, r}; break; } r -= I_GU; \
            if (r < I_D) { d_ = P0Item{a.in[4], DFF, DM, W1d, ID_PLAIN, nullptr, nullptr, 0, r}; break; } r -= I_D; \
            if (r < I_D) { d_ = P0Item{a.in[19], DFF, DM, W2d, ID_PLAIN, nullptr, nullptr, 0, r}; break; } r -= I_D; \
            if (r < I_IN) { d_ = P0Item{a.in[6], DM, 1184, Win, ID_IN, a.in[5], a.in[5], DM, r}; break; } r -= I_IN; \
            if (r < I_QB) { d_ = P0Item{a.in[8], 256, NQ, Wqb, ID_QB, a.in[7], a.in[7], 256, r}; break; } r -= I_QB; \
            if (r < I_KVB) { d_ = P0Item{a.in[10], 128, NKV, Wkvb, ID_PLAIN, a.in[9], a.in[9], 128, r}; break; } r -= I_KVB; \
            d_ = P0Item{a.in[15], DM, DM, Wo, ID_PLAIN, a.in[13], a.in[14], 512, r}; } while (0)
        if (gw < NITEMS) {
            P0Item dc, dn; float rc[32], rn[32];
            P0_DECODE(gw, dc); p0_item_load(dc, rc, lane);
            for (int it = gw; it < NITEMS; it += NGW) {
                const bool hn = it + NGW < NITEMS;
                if (hn) { P0_DECODE(it + NGW, dn); p0_item_load(dn, rn, lane); }
                p0_item_finish(dc, rc, scr, lane);
                if (hn) { dc = dn;
#pragma unroll
                    for (int i = 0; i < 32; ++i) rc[i] = rn[i]; }
            }
        }
#undef P0_DECODE
        const int gt = bx * 512 + tid, NGT = G * 512;
        for (int i = gt; i < 96 * DM / 8; i += NGT) ((u32x4*)(Win + (size_t)416 * DM))[i] = (u32x4){0u, 0u, 0u, 0u};
#if defined(DBG_NAIVE_WIN)
        __syncthreads();
        if (bx == 0) { asm volatile("s_waitcnt vmcnt(0)" ::: "memory"); }
#endif
        for (int i = gt; i < SEQ * 16; i += NGT) { const int pos = i >> 4, k = i & 15; const float inv = exp2f(-(float)(2 * k) * (1.0f / 32.0f) * 13.287712379549449f);
            float c, s; sincos_acc((float)pos * inv, c, s); rope[i] = (f32x2){c, s}; }
#if defined(DBG_NAIVE_WIN)
        for (int i = gt; i < DM * 1184; i += NGT) { const int k = i / 1184, n = i % 1184; int drow; float sc; map_dest(ID_IN, n, drow, sc);
            Win[(size_t)drow * DM + k] = (bf16_t)f2bf(a.in[6][i] * a.in[5][k] * sc); }
#endif
        for (int i = gt; i < 8 * 128; i += NGT) { const int hh = i >> 7, d = i & 127; int bk = d;
            if (d >= 16) { bk = 16 + (int)(logf((float)d / 16.0f) / 2.0794415416798357f * 16.0f); if (bk > 31) bk = 31; }
            biasT[i] = a.in[12][bk * 8 + hh] * LOG2E; }
        for (int m = gw; m < MTOK; m += NGW) {
            const f32x4* xr = (const f32x4*)(x + (size_t)m * DM) + lane; f32x4 v[4]; float s = 0.f;
#pragma unroll
            for (int j = 0; j < 4; ++j) { v[j] = xr[64 * j]; s += sq4(v[j]); }
            s = wave_sum(s);
            unsigned long long* o8 = (unsigned long long*)(HB + (size_t)m * DM) + lane;
#pragma unroll
            for (int j = 0; j < 4; ++j) o8[64 * j] = (unsigned long long)cvt_pk_bf16(v[j].x, v[j].y) | ((unsigned long long)cvt_pk_bf16(v[j].z, v[j].w) << 32);
            if (lane < 16) stats[(size_t)m * 16 + lane] = (lane == 0) ? s : 0.f;
        }
        __syncthreads();
    }
    SEAM(0);
#define TAB_FILL(expr_a, expr_b) do { for (int idx = tid; idx < 1024; idx += 512) { const int r = tab_row(bx, idx); float va, vb; { expr_a; } { expr_b; } \
        *(LAS float*)(lds + TAB_OFF + 4 * idx) = va; *(LAS float*)(lds + TABB_OFF + 4 * idx) = vb; } __syncthreads(); } while (0)
#define SUM16(p) ({ const f32x4* q_ = (const f32x4*)((p) + (size_t)r * 16); sum4(q_[0]) + sum4(q_[1]) + sum4(q_[2]) + sum4(q_[3]); })
#define FFN_UP(Wgu) do { TAB_FILL(va = rsq(SUM16(stats) * (1.0f / DM) + EPS), vb = 0.f); \
        pg8::Gemm g{HB, Wgu, MTOK, 2 * DFF, DM, DM, DM}; pg8::StaticOrder S; S.init(MTOK, 2 * DFF, G, bx); EpiSwiGLU E{hid, lds}; \
        pg8::gemm_phase(lds, g, S, E, pg8::NoMid{}); } while (0)
    if (IN(1)) FFN_UP(W1gu);
    SEAM(1);
    if (IN(2)) { pg8::Gemm g{hid, W1d, MTOK, DM, DFF, DFF, DFF}; pg8::StaticOrder S; S.init(MTOK, DM, G, bx); EpiResid<false> E{HB, stats, 0.5f, lds};
        pg8::gemm_phase(lds, g, S, E, pg8::NoMid{}); }
    SEAM(2);
    if (IN(3)) { TAB_FILL(va = rsq(SUM16(stats) * (1.0f / DM) + EPS), vb = 0.f);
        pg8::Gemm g{HB, Win, MTOK, NPROJ, DM, DM, DM}; pg8::StaticOrder S; S.init(MTOK, NPROJ, G, bx); EpiProj E{proj, pq, pkv, rope, lds};
        pg8::gemm_phase(lds, g, S, E, pg8::NoMid{}); }
    SEAM(3);
    if (IN(4)) {
        TAB_FILL(va = rsq(sum4(*(const f32x4*)(pq + (size_t)r * 4)) * (1.0f / 256.0f) + EPS) * (0.10206207261596575f * LOG2E), vb = rsq(sum4(*(const f32x4*)(pkv + (size_t)r * 4)) * (1.0f / 128.0f) + EPS));
        { pg8::Gemm g{proj, Wqb, MTOK, NQ, 256, NPROJ, 256}; pg8::StaticOrder S; S.init(MTOK, NQ, G, bx); EpiQ E{qmla, rope, lds};
          pg8::gemm_phase(lds, g, S, E, pg8::NoMid{}); }
        { pg8::Gemm g{proj + 256, Wkvb, MTOK, NKV, 128, NPROJ, 128}; pg8::StaticOrder S; S.init(MTOK, NKV, G, bx); EpiKV E{kvb, lds};
          pg8::gemm_phase(lds, g, S, E, pg8::NoMid{}); }
    }
    SEAM(4);
    if (IN(5)) {
        const AttnT T{qmla, kvb, proj, ob, po, biasT, a.in[11]};
        for (int uu = bx; uu < 256; uu += G) {
            const int b = (uu & 7) * 4 + (uu >> 6), h = (uu >> 3) & 7;
            for (int qb = 7; qb >= 0; --qb) attn_unit<false>(lds, b, h, qb, T, false);
            for (int i = 0; i < 8; ++i) attn_unit<true>(lds, b, h >> 2, (h & 3) * 8 + i, T, i != 0);
        }
    }
    SEAM(5);
    if (IN(6)) {
        TAB_FILL(const f32x4* q_ = (const f32x4*)(po + (size_t)r * 16); const float mla_ = sum4(q_[0]) + sum4(q_[1]); const float swa_ = sum4(q_[2]) + sum4(q_[3]);
                 va = rsq(mla_ * (1.0f / 512.0f) + EPS) * sqrtf(swa_ * (1.0f / 512.0f) + EPS),
                 const f32x4* q2_ = (const f32x4*)(po + (size_t)r * 16); vb = rsq((sum4(q2_[2]) + sum4(q2_[3])) * (1.0f / 512.0f) + EPS));
        pg8::Gemm g{ob, Wo, MTOK, DM, DM, DM, DM}; pg8::StaticOrder S; S.init(MTOK, DM, G, bx); EpiResid<true> E{HB, stats, 1.0f, lds}; MidWo Md{lds};
        pg8::gemm_phase(lds, g, S, E, Md); }
    SEAM(6);
    if (IN(7)) FFN_UP(W2gu);
    SEAM(7);
    if (IN(8)) { pg8::Gemm g{hid, W2d, MTOK, DM, DFF, DFF, DFF}; pg8::StaticOrder S; S.init(MTOK, DM, G, bx);
        EpiFinal E{HB, stats, a.out, a.in[20], (unsigned*)(ws + WS_BAR + 16384), 0.5f};
        pg8::gemm_phase(lds, g, S, E, pg8::NoMid{}); }
#undef IN
#undef SEAM
}

extern "C" void kernel_launch(void* const* d_in, const int* in_sizes, int n_in, void* d_out, int out_size, void* d_ws, size_t ws_size, hipStream_t stream) {
    static int grid = 0;
    if (grid == 0) {
        if (n_in != 21 || out_size != MTOK * DM || ws_size < WS_END) { fprintf(stderr, "kernel_launch: unexpected shapes (n_in %d, out %d, ws %zu)\n", n_in, out_size, ws_size); grid = -1; return; }
        int dev = 0, cus = 0, per_cu = 0;
        hipGetDevice(&dev); hipDeviceGetAttribute(&cus, hipDeviceAttributeMultiprocessorCount, dev);
        if (hipFuncSetAttribute((const void*)mk_fwd, hipFuncAttributeMaxDynamicSharedMemorySize, LDS_BYTES) != hipSuccess) { fprintf(stderr, "kernel_launch: hipFuncSetAttribute failed\n"); grid = -1; return; }
        if (hipOccupancyMaxActiveBlocksPerMultiprocessor(&per_cu, (const void*)mk_fwd, 512, LDS_BYTES) != hipSuccess || per_cu < 1) { fprintf(stderr, "kernel_launch: occupancy query gave %d\n", per_cu); per_cu = 1; }
        (void)hipGetLastError();
        grid = cus * 1;
        if (grid > 256) grid = 256;
    }
    if (grid < 0) return;
    Args a{};
    for (int i = 0; i < 21; ++i) a.in[i] = (const float*)d_in[i];
    a.out = (float*)d_out; a.ws = (unsigned char*)d_ws;
    if (hipMemsetAsync((char*)d_ws + WS_BAR, 0, BAR_BYTES, stream) != hipSuccess) { fprintf(stderr, "kernel_launch: memset failed\n"); return; }
#if MK_ONE_LAUNCH
    a.ph_lo = 0; a.ph_hi = NPHASE;
    void* args[] = {&a};
    hipError_t e = hipLaunchCooperativeKernel((const void*)mk_fwd, dim3(grid), dim3(512), args, LDS_BYTES, stream);
    if (e != hipSuccess) fprintf(stderr, "cooperative launch failed: %s (grid %d)\n", hipGetErrorString(e), grid);
#else
    for (int p = 0; p < NPHASE; ++p) { a.ph_lo = p; a.ph_hi = p + 1; hipLaunchKernelGGL(mk_fwd, dim3(grid), dim3(512), LDS_BYTES, stream, a); }
#endif
}
```

```cpp
#include <hip/hip_runtime.h>
#include <hip/hip_cooperative_groups.h>
#include <cstdio>
#include <cstdint>
namespace cg = cooperative_groups;

#ifndef MK_ONE_LAUNCH
#define MK_ONE_LAUNCH 1
#endif

#define LAS __attribute__((address_space(3)))
typedef unsigned short bf16_t;
typedef short bf16x8 __attribute__((ext_vector_type(8)));
typedef short s16x4 __attribute__((ext_vector_type(4)));
typedef float f32x4 __attribute__((ext_vector_type(4)));
typedef float f32x2 __attribute__((ext_vector_type(2)));
typedef unsigned u32x4 __attribute__((ext_vector_type(4)));
typedef unsigned u32x2 __attribute__((ext_vector_type(2)));

constexpr int MTOK = 65536, DM = 1024, DFF = 2816, SEQ = 2048, NPROJ = 1280, NQ = 768, NKV = 1024;
constexpr float EPS = 1e-6f;
constexpr float LOG2E = 1.4426950408889634f;
constexpr int PC_KPE = 384, PC_QS = 512, PC_KS = 1024, PC_VS = 1152;

constexpr size_t MiB = 1u << 20;
constexpr size_t WS_ROPE = 0;
constexpr size_t WS_BIAS = 512 * 1024;
constexpr size_t WS_BAR = 1 * MiB, BAR_BYTES = 32768;
constexpr size_t WS_STATS = 4 * MiB;
constexpr size_t WS_PQ = 8 * MiB;
constexpr size_t WS_PKV = 9 * MiB;
constexpr size_t WS_PO = 10 * MiB;
constexpr size_t WS_W1GU = 16 * MiB, WS_W1D = 27 * MiB, WS_W2GU = 33 * MiB, WS_W2D = 44 * MiB, WS_WIN = 50 * MiB, WS_WQB = 53 * MiB, WS_WKVB = 54 * MiB, WS_WO = 55 * MiB;
constexpr size_t WS_HID = 64 * MiB;
constexpr size_t WS_PROJ = 64 * MiB;
constexpr size_t WS_QMLA = 224 * MiB;
constexpr size_t WS_KV = 416 * MiB;
constexpr size_t WS_O = 544 * MiB;
constexpr size_t WS_HB = 672 * MiB;
constexpr size_t WS_END = 800 * MiB;

constexpr int LDS_BYTES = 147456;

typedef __bf16 bf16x2_t __attribute__((ext_vector_type(2)));
__device__ __forceinline__ unsigned cvt_pk_bf16(float lo, float hi) { const f32x2 v = {lo, hi}; const bf16x2_t b = __builtin_convertvector(v, bf16x2_t); return __builtin_bit_cast(unsigned, b); }
__device__ __forceinline__ float wave_sum(float v) {
#pragma unroll
    for (int o = 1; o < 64; o <<= 1) v += __shfl_xor(v, o);
    return v;
}
__device__ __forceinline__ float sum4(f32x4 v) { return (v.x + v.y) + (v.z + v.w); }
__device__ __forceinline__ float sq4(f32x4 v) { return (v.x * v.x + v.y * v.y) + (v.z * v.z + v.w * v.w); }
__device__ __forceinline__ float quad_sum(float s) {
    auto a = __builtin_amdgcn_permlane16_swap(__float_as_uint(s), __float_as_uint(s), false, false); s = __uint_as_float(a[0]) + __uint_as_float(a[1]);
    auto b = __builtin_amdgcn_permlane32_swap(__float_as_uint(s), __float_as_uint(s), false, false); return __uint_as_float(b[0]) + __uint_as_float(b[1]);
}
__device__ __forceinline__ float quad_max(float s) {
    auto a = __builtin_amdgcn_permlane16_swap(__float_as_uint(s), __float_as_uint(s), false, false); s = fmaxf(__uint_as_float(a[0]), __uint_as_float(a[1]));
    auto b = __builtin_amdgcn_permlane32_swap(__float_as_uint(s), __float_as_uint(s), false, false); return fmaxf(__uint_as_float(b[0]), __uint_as_float(b[1]));
}
__device__ __forceinline__ float rsq(float x) { return __builtin_amdgcn_rsqf(x); }

namespace pg8 {
constexpr int BM = 256, BK = 64, HALF = 128, HTB = HALF * BK * 2, STAGE_BYTES = 8 * HTB, NXCD = 8, WGM = 8;
__host__ __device__ __forceinline__ int lds_byte(int r, int c) { const int st = (r >> 4) * 2 + (c >> 5), rr = r & 15, cc = c & 31, ob = rr * 64 + cc * 2; return st * 1024 + (ob ^ (((ob >> 9) & 1) << 5)); }
__host__ __device__ __forceinline__ void stage_rc(int b, int& R, int& C) { const int st = b / 1024, sb = b % 1024, swz = sb ^ (((sb >> 9) & 1) << 5); R = (st >> 1) * 16 + swz / 64; C = (st & 1) * 32 + (swz % 64) / 2; }
__host__ __device__ __forceinline__ int perm32(int rho) { const int n = rho >> 4, i = rho & 15; return 8 * (i >> 2) + 4 * n + (i & 3); }

struct Unit { int pm, pn; };
struct Gemm { const bf16_t* A; const bf16_t* Bt; int M, N, K, lda, ldb; };

struct StaticOrder {
    int nM, nN, nwg, G, c;
    __device__ void init(int M, int N, int G_, int c_) { nM = M / BM; nN = N / BM; nwg = nM * nN; G = G_; c = c_; }
    __device__ bool next(int i, Unit& u) const {
        const long L = (long)i * G + c; if (L >= nwg) return false;
        int wgid = (int)L; { const int q = nwg / NXCD, r = nwg % NXCD, xcd = wgid % NXCD, off = wgid / NXCD; wgid = (xcd < r ? xcd * (q + 1) : r * (q + 1) + (xcd - r) * q) + off; }
        const int nig = WGM * nN, gid = wgid / nig, fm = gid * WGM, gsz = (nM - fm) < WGM ? (nM - fm) : WGM;
        u.pm = fm + ((wgid % nig) % gsz); u.pn = (wgid % nig) / gsz; return true;
    }
};
struct NoMid { static constexpr bool ON = false; __device__ __forceinline__ void apply(f32x4 (&)[2][2][4][2], const Unit&, int, int, int) const {} };

template <class Epi, class Mid>
__device__ __forceinline__ void gemm_phase(LAS unsigned char* lds, const Gemm g, const StaticOrder& S, const Epi& E, const Mid& Md) {
    const int tid = threadIdx.x, wid = __builtin_amdgcn_readfirstlane(tid >> 6), lane = tid & 63, wr = wid >> 2, wc = wid & 3, fr = lane & 15, fq = lane >> 4;
    int K = g.K; asm volatile("" : "+s"(K)); const int nt = K / BK;
    unsigned voffA[2], voffB[2];
#pragma unroll
    for (int i = 0; i < 2; ++i) { int R, C; stage_rc(tid * 16 + i * 8192, R, C); const int Rb = Epi::PERM ? ((R & ~31) + perm32(R & 31)) : R;
        voffA[i] = (unsigned)(R * g.lda + C) * 2u; voffB[i] = (unsigned)(Rb * g.ldb + C) * 2u; }
    const size_t kstep = (size_t)(BK * 2);
    const size_t hsA = (size_t)HALF * g.lda * 2, hsB = (size_t)HALF * g.ldb * 2, tsA = 2 * hsA, tsB = 2 * hsB;
    const unsigned ldsw = (unsigned)wid * 1024u;
    const int aoff = lds_byte(wr * 64 + fr, fq * 8), boff = lds_byte(wc * 32 + fr, fq * 8);
#define PG8_SA(b, h) (((b) * 2 + (h)) * HTB)
#define PG8_SB(b, h) ((4 + (b) * 2 + (h)) * HTB)
#define PG8_STAGE(bufoff, gbase, voff) do { _Pragma("unroll") for (int _i = 0; _i < 2; ++_i) \
        __builtin_amdgcn_global_load_lds((const unsigned*)((const char*)(gbase) + (voff)[_i]), (LAS unsigned*)(lds + (bufoff) + ldsw + _i * 8192), 16, 0, 0); } while (0)
#define PG8_LDA(dst, b, h) do { _Pragma("unroll") for (int m = 0; m < 4; ++m) _Pragma("unroll") for (int k = 0; k < 2; ++k) dst[m][k] = *(const LAS bf16x8*)(lds + PG8_SA(b, h) + aoff + m * 2048 + k * 1024); } while (0)
#define PG8_LDB(dst, b, h) do { _Pragma("unroll") for (int n = 0; n < 2; ++n) _Pragma("unroll") for (int k = 0; k < 2; ++k) dst[n][k] = *(const LAS bf16x8*)(lds + PG8_SB(b, h) + boff + n * 2048 + k * 1024); } while (0)
#define PG8_MMA(ai, bj, At, Bt) do { __builtin_amdgcn_s_setprio(1); _Pragma("unroll") for (int m = 0; m < 4; ++m) _Pragma("unroll") for (int n = 0; n < 2; ++n) _Pragma("unroll") for (int k = 0; k < 2; ++k) \
        acc[ai][bj][m][n] = __builtin_amdgcn_mfma_f32_16x16x32_bf16(Bt[n][k], At[m][k], acc[ai][bj][m][n], 0, 0, 0); __builtin_amdgcn_s_setprio(0); } while (0)
#define PG8_WAIT_V(n) asm volatile("s_waitcnt vmcnt(" #n ")" ::: "memory")
#define PG8_WAIT_L(n) asm volatile("s_waitcnt lgkmcnt(" #n ")" ::: "memory")
#define PG8_BAR __builtin_amdgcn_s_barrier()
#define PG8_SCHED __builtin_amdgcn_sched_barrier(0)
    Unit cur, nxt; int ui = 0;
    if (!S.next(0, cur)) return;
    f32x4 acc[2][2][4][2];
#pragma unroll
    for (int a = 0; a < 2; ++a)
#pragma unroll
        for (int b = 0; b < 2; ++b)
#pragma unroll
            for (int m = 0; m < 4; ++m)
#pragma unroll
                for (int n = 0; n < 2; ++n) acc[a][b][m][n] = (f32x4){0.f, 0.f, 0.f, 0.f};
    bf16x8 At[4][2], B0[2][2], B1[2][2];
    const char* cA = (const char*)g.A + (size_t)cur.pm * tsA; const char* cB = (const char*)g.Bt + (size_t)cur.pn * tsB;
    PG8_STAGE(PG8_SB(0, 0), cB, voffB); PG8_STAGE(PG8_SB(0, 1), cB + hsB, voffB); PG8_STAGE(PG8_SA(0, 0), cA, voffA); PG8_STAGE(PG8_SA(0, 1), cA + hsA, voffA);
    if (wr == 1) PG8_BAR;
    PG8_WAIT_V(2); PG8_BAR;
    PG8_STAGE(PG8_SB(1, 0), cB + kstep, voffB); PG8_STAGE(PG8_SA(1, 0), cA + kstep, voffA); PG8_STAGE(PG8_SB(1, 1), cB + hsB + kstep, voffB);
    PG8_WAIT_V(6); PG8_BAR;
    for (;;) {
        const bool has_next = S.next(ui + 1, nxt);
        const char* nA = has_next ? (const char*)g.A + (size_t)nxt.pm * tsA : cA; const char* nB = has_next ? (const char*)g.Bt + (size_t)nxt.pn * tsB : cB;
        for (int t = 0; t < nt; t += 2) {
            const bool last = (t == nt - 2);
            const char* a1 = cA + (size_t)(t + 1) * kstep;
            const char* a2 = last ? nA : cA + (size_t)(t + 2) * kstep; const char* b2 = last ? nB : cB + (size_t)(t + 2) * kstep;
            const char* a3 = a2 + kstep; const char* b3 = b2 + kstep;
            if constexpr (Mid::ON) { if (t * 2 == nt && t != 0) Md.apply(acc, cur, wr, fr, fq); }
            PG8_LDB(B0, 0, 0); PG8_LDB(B1, 0, 1); PG8_SCHED; PG8_LDA(At, 0, 0); PG8_STAGE(PG8_SA(1, 1), a1 + hsA, voffA);
            PG8_WAIT_V(8); PG8_WAIT_L(0); PG8_BAR; PG8_MMA(0, 0, At, B0); PG8_MMA(0, 1, At, B1); PG8_BAR; PG8_SCHED;
            PG8_LDA(At, 0, 1); PG8_STAGE(PG8_SB(0, 0), b2, voffB); PG8_STAGE(PG8_SB(0, 1), b2 + hsB, voffB); PG8_STAGE(PG8_SA(0, 0), a2, voffA);
            PG8_WAIT_V(8); PG8_WAIT_L(0); PG8_BAR; PG8_MMA(1, 0, At, B0); PG8_MMA(1, 1, At, B1); PG8_BAR; PG8_SCHED;
            PG8_LDB(B0, 1, 0); PG8_LDB(B1, 1, 1); PG8_SCHED; PG8_LDA(At, 1, 0); PG8_STAGE(PG8_SA(0, 1), a2 + hsA, voffA);
            PG8_WAIT_V(8); PG8_WAIT_L(0); PG8_BAR; PG8_MMA(0, 0, At, B0); PG8_MMA(0, 1, At, B1); PG8_BAR; PG8_SCHED;
            PG8_LDA(At, 1, 1); PG8_STAGE(PG8_SB(1, 0), b3, voffB); PG8_STAGE(PG8_SB(1, 1), b3 + hsB, voffB); PG8_STAGE(PG8_SA(1, 0), a3, voffA);
            PG8_WAIT_V(8); PG8_WAIT_L(0); PG8_BAR; PG8_MMA(1, 0, At, B0); PG8_MMA(1, 1, At, B1); PG8_BAR; PG8_SCHED;
        }
        if (wr == 0) PG8_BAR;
        E(acc, cur, wr, wc, fr, fq);
        if (!has_next) break;
#pragma unroll
        for (int a = 0; a < 2; ++a)
#pragma unroll
            for (int b = 0; b < 2; ++b)
#pragma unroll
                for (int m = 0; m < 4; ++m)
#pragma unroll
                    for (int n = 0; n < 2; ++n) acc[a][b][m][n] = (f32x4){0.f, 0.f, 0.f, 0.f};
        cur = nxt; cA = nA; cB = nB; ++ui;
        if (wr == 1) PG8_BAR;
    }
    PG8_WAIT_V(0);
    PG8_BAR;
#undef PG8_SA
#undef PG8_SB
#undef PG8_STAGE
#undef PG8_LDA
#undef PG8_LDB
#undef PG8_MMA
#undef PG8_WAIT_V
#undef PG8_WAIT_L
#undef PG8_BAR
#undef PG8_SCHED
}
}

typedef const f32x4 (&AccRef)[2][2][4][2];
constexpr int TAB_OFF = 131072, TABB_OFF = TAB_OFF + 4096;
__device__ __forceinline__ int tab_idx(int pm, int r) { return (((pm >> 3) & 3) << 8) | (r & 255); }
__device__ __forceinline__ float tabA(LAS unsigned char* lds, int pm, int r) { return *(const LAS float*)(lds + TAB_OFF + 4 * tab_idx(pm, r)); }
__device__ __forceinline__ float tabB(LAS unsigned char* lds, int pm, int r) { return *(const LAS float*)(lds + TABB_OFF + 4 * tab_idx(pm, r)); }
__device__ __forceinline__ int tab_row(int bx, int idx) { return (8 * (4 * (bx & 7) + (idx >> 8)) + ((bx >> 3) & 7)) * 256 + (idx & 255); }

__device__ __forceinline__ f32x4 silu_mul(f32x4 g, f32x4 u, float rstd) {
    const float c2 = -LOG2E * rstd, r2 = rstd * rstd; f32x4 o;
#pragma unroll
    for (int h = 0; h < 2; ++h) {
        const f32x2 gg = (f32x2){g[2 * h], g[2 * h + 1]}, uu = (f32x2){u[2 * h], u[2 * h + 1]};
        const f32x2 ar = gg * c2; f32x2 e; e.x = __builtin_amdgcn_exp2f(ar.x); e.y = __builtin_amdgcn_exp2f(ar.y);
        const f32x2 d = e + 1.0f; f32x2 r; r.x = __builtin_amdgcn_rcpf(d.x); r.y = __builtin_amdgcn_rcpf(d.y);
        const f32x2 p = ((gg * uu) * r2) * r;
        o[2 * h] = p.x; o[2 * h + 1] = p.y;
    }
    return o;
}
__device__ __forceinline__ u32x4 pack8(f32x4 a, f32x4 b) { u32x4 w; w.x = cvt_pk_bf16(a[0], a[1]); w.y = cvt_pk_bf16(a[2], a[3]); w.z = cvt_pk_bf16(b[0], b[1]); w.w = cvt_pk_bf16(b[2], b[3]); return w; }
__device__ __forceinline__ f32x4 bf_lo4(u32x4 w) { return (f32x4){__builtin_bit_cast(float, w.x << 16), __builtin_bit_cast(float, w.x & 0xffff0000u), __builtin_bit_cast(float, w.y << 16), __builtin_bit_cast(float, w.y & 0xffff0000u)}; }
__device__ __forceinline__ f32x4 bf_hi4(u32x4 w) { return (f32x4){__builtin_bit_cast(float, w.z << 16), __builtin_bit_cast(float, w.z & 0xffff0000u), __builtin_bit_cast(float, w.w << 16), __builtin_bit_cast(float, w.w & 0xffff0000u)}; }
__device__ __forceinline__ void rot8(f32x4& v0, f32x4& v1, f32x4 t0, f32x4 t1) {
    const f32x4 a = v0, b = v1;
    v0[0] = a[0] * t0[0] - a[1] * t0[1]; v0[1] = a[1] * t0[0] + a[0] * t0[1]; v0[2] = a[2] * t0[2] - a[3] * t0[3]; v0[3] = a[3] * t0[2] + a[2] * t0[3];
    v1[0] = b[0] * t1[0] - b[1] * t1[1]; v1[1] = b[1] * t1[0] + b[0] * t1[1]; v1[2] = b[2] * t1[2] - b[3] * t1[3]; v1[3] = b[3] * t1[2] + b[2] * t1[3];
}

struct EpiSwiGLU {
    static constexpr bool PERM = true;
    bf16_t* O; LAS unsigned char* lds;
    __device__ __forceinline__ void operator()(AccRef acc, const pg8::Unit& u, int wr, int wc, int fr, int fq) const {
        const int row0 = u.pm * 256 + wr * 64 + fr, col0 = u.pn * 128 + wc * 32 + 8 * fq;
#pragma unroll
        for (int ai = 0; ai < 2; ++ai)
#pragma unroll
            for (int m = 0; m < 4; ++m) {
                const int r = row0 + ai * 128 + m * 16; const float rstd = tabA(lds, u.pm, r);
                const f32x4 v0 = silu_mul(acc[ai][0][m][0], acc[ai][1][m][0], rstd), v1 = silu_mul(acc[ai][0][m][1], acc[ai][1][m][1], rstd);
                __builtin_nontemporal_store(pack8(v0, v1), (u32x4*)(O + (size_t)r * DFF + col0));
            }
    }
};

template <bool USE_TAB>
struct EpiResid {
    static constexpr bool PERM = true;
    bf16_t* HBo; float* stats; float alpha; LAS unsigned char* lds;
    __device__ __forceinline__ void operator()(AccRef acc, const pg8::Unit& u, int wr, int wc, int fr, int fq) const {
        const int row0 = u.pm * 256 + wr * 64 + fr, c0 = u.pn * 256 + wc * 32 + 8 * fq;
        u32x4 bs[8][2];
#define RES_LOAD(it_) do { const u32x4* p = (const u32x4*)(HBo + (size_t)(row0 + ((it_) >> 2) * 128 + ((it_) & 3) * 16) * DM + c0); bs[it_][0] = p[0]; bs[it_][1] = p[16]; } while (0)
        RES_LOAD(0); RES_LOAD(1); RES_LOAD(2); RES_LOAD(3);
#pragma unroll
        for (int it = 0; it < 8; ++it) {
            if (it + 4 < 8) { RES_LOAD((it + 4) & 7); }
            const int ai = it >> 2, m = it & 3, r = row0 + ai * 128 + m * 16;
            const float sc = USE_TAB ? tabB(lds, u.pm, r) : alpha;
            float ss = 0.f;
#pragma unroll
            for (int bj = 0; bj < 2; ++bj) {
                const f32x4 v0 = bf_lo4(bs[it][bj]) + acc[ai][bj][m][0] * sc, v1 = bf_hi4(bs[it][bj]) + acc[ai][bj][m][1] * sc;
                ss += sq4(v0) + sq4(v1);
                *(u32x4*)(HBo + (size_t)r * DM + c0 + bj * 128) = pack8(v0, v1);
            }
            ss = quad_sum(ss);
            if (fq == 0) stats[(size_t)r * 16 + u.pn * 4 + wc] = ss;
        }
#undef RES_LOAD
    }
};
struct EpiFinal {
    static constexpr bool PERM = true;
    const bf16_t* HBi; float* stats; float* out; const float* gfin; unsigned* pcnt; float alpha;
    __device__ __forceinline__ void operator()(AccRef acc, const pg8::Unit& u, int wr, int wc, int fr, int fq) const {
        const int row0 = u.pm * 256 + wr * 64 + fr, c0 = u.pn * 256 + wc * 32 + 8 * fq;
        f32x4 v[8][2][2];
        u32x4 bs[8][2];
#define FIN_LOAD(it_) do { const u32x4* p = (const u32x4*)(HBi + (size_t)(row0 + ((it_) >> 2) * 128 + ((it_) & 3) * 16) * DM + c0); bs[it_][0] = p[0]; bs[it_][1] = p[16]; } while (0)
        FIN_LOAD(0); FIN_LOAD(1); FIN_LOAD(2); FIN_LOAD(3);
#pragma unroll
        for (int it = 0; it < 8; ++it) {
            if (it + 4 < 8) { FIN_LOAD((it + 4) & 7); }
            const int ai = it >> 2, m = it & 3, r = row0 + ai * 128 + m * 16;
            float ss = 0.f;
#pragma unroll
            for (int bj = 0; bj < 2; ++bj) {
                v[it][bj][0] = bf_lo4(bs[it][bj]) + acc[ai][bj][m][0] * alpha; v[it][bj][1] = bf_hi4(bs[it][bj]) + acc[ai][bj][m][1] * alpha;
                ss += sq4(v[it][bj][0]) + sq4(v[it][bj][1]);
            }
            ss = quad_sum(ss);
            if (fq == 0) __hip_atomic_store(stats + (size_t)r * 16 + u.pn * 4 + wc, ss, __ATOMIC_RELAXED, __HIP_MEMORY_SCOPE_AGENT);
        }
#undef FIN_LOAD
        asm volatile("s_waitcnt vmcnt(0)" ::: "memory");
        __builtin_amdgcn_s_barrier();
        if (threadIdx.x == 0) {
            unsigned* c = pcnt + 16 * u.pm;
            __hip_atomic_fetch_add(c, 1u, __ATOMIC_RELAXED, __HIP_MEMORY_SCOPE_AGENT);
            unsigned spins = 0;
            while (__hip_atomic_load(c, __ATOMIC_RELAXED, __HIP_MEMORY_SCOPE_AGENT) < 4u) { __builtin_amdgcn_s_sleep(1); if (++spins > (1u << 22)) break; }
            __builtin_amdgcn_fence(__ATOMIC_ACQUIRE, "agent");
            asm volatile("s_waitcnt vmcnt(0)" ::: "memory");
        }
        __builtin_amdgcn_s_barrier();
        asm volatile("" ::: "memory");
        f32x4 gf[2][2];
#pragma unroll
        for (int bj = 0; bj < 2; ++bj) { gf[bj][0] = *(const f32x4*)(gfin + c0 + bj * 128); gf[bj][1] = *(const f32x4*)(gfin + c0 + bj * 128 + 4); }
#pragma unroll
        for (int it = 0; it < 8; ++it) {
            const int r = row0 + (it >> 2) * 128 + (it & 3) * 16;
            const float* sp = stats + (size_t)r * 16 + 4 * fq;
            f32x4 st; st.x = __hip_atomic_load(sp, __ATOMIC_RELAXED, __HIP_MEMORY_SCOPE_AGENT); st.y = __hip_atomic_load(sp + 1, __ATOMIC_RELAXED, __HIP_MEMORY_SCOPE_AGENT);
            st.z = __hip_atomic_load(sp + 2, __ATOMIC_RELAXED, __HIP_MEMORY_SCOPE_AGENT); st.w = __hip_atomic_load(sp + 3, __ATOMIC_RELAXED, __HIP_MEMORY_SCOPE_AGENT);
            const float rstd = 1.0f / sqrtf(quad_sum(sum4(st)) * (1.0f / DM) + EPS);
#pragma unroll
            for (int bj = 0; bj < 2; ++bj) { float* op = out + (size_t)r * DM + c0 + bj * 128;
                __builtin_nontemporal_store(v[it][bj][0] * rstd * gf[bj][0], (f32x4*)op); __builtin_nontemporal_store(v[it][bj][1] * rstd * gf[bj][1], (f32x4*)(op + 4)); }
        }
    }
};
struct MidWo {
    static constexpr bool ON = true;
    LAS unsigned char* lds;
    __device__ __forceinline__ void apply(f32x4 (&acc)[2][2][4][2], const pg8::Unit& u, int wr, int fr, int fq) const {
        const int row0 = u.pm * 256 + wr * 64 + fr;
#pragma unroll
        for (int ai = 0; ai < 2; ++ai)
#pragma unroll
            for (int m = 0; m < 4; ++m) {
                const float ratio = tabA(lds, u.pm, row0 + ai * 128 + m * 16);
#pragma unroll
                for (int bj = 0; bj < 2; ++bj)
#pragma unroll
                    for (int n = 0; n < 2; ++n) acc[ai][bj][m][n] = acc[ai][bj][m][n] * ratio;
            }
    }
};
struct EpiProj {
    static constexpr bool PERM = true;
    bf16_t* P; float* pq; float* pkv; const f32x2* rope; LAS unsigned char* lds;
    __device__ __forceinline__ void operator()(AccRef acc, const pg8::Unit& u, int wr, int wc, int fr, int fq) const {
        const int row0 = u.pm * 256 + wr * 64 + fr, col0 = u.pn * 256 + wc * 32 + 8 * fq;
        const bool is0 = (u.pn == 0), is1 = (u.pn == 1), dorope = is1 && (wc == 0);
#pragma unroll
        for (int ai = 0; ai < 2; ++ai)
#pragma unroll
            for (int m = 0; m < 4; ++m) {
                const int r = row0 + ai * 128 + m * 16; const float rstd = tabA(lds, u.pm, r);
                f32x4 v00 = acc[ai][0][m][0] * rstd, v01 = acc[ai][0][m][1] * rstd, v10 = acc[ai][1][m][0] * rstd, v11 = acc[ai][1][m][1] * rstd;
                if (is0 | is1) { float ss = sq4(v00) + sq4(v01); if (is0) ss += sq4(v10) + sq4(v11); ss = quad_sum(ss); if (fq == 0) (is0 ? pq : pkv)[(size_t)r * 4 + wc] = ss; }
                {
                    f32x4 t0 = (f32x4){1.f, 0.f, 1.f, 0.f}, t1 = t0;
                    if (dorope) { const f32x4* tp = (const f32x4*)(rope + (size_t)(r & (SEQ - 1)) * 16 + 4 * fq); t0 = tp[0]; t1 = tp[1]; }
                    rot8(v10, v11, t0, t1);
                }
                *(u32x4*)(P + (size_t)r * NPROJ + col0) = pack8(v00, v01);
                *(u32x4*)(P + (size_t)r * NPROJ + col0 + 128) = pack8(v10, v11);
            }
    }
};
struct EpiQ {
    static constexpr bool PERM = true;
    bf16_t* Q; const f32x2* rope; LAS unsigned char* lds;
    __device__ __forceinline__ void operator()(AccRef acc, const pg8::Unit& u, int wr, int wc, int fr, int fq) const {
        const int row0 = u.pm * 256 + wr * 64 + fr, col0 = u.pn * 256 + wc * 32 + 8 * fq;
#pragma unroll
        for (int ai = 0; ai < 2; ++ai)
#pragma unroll
            for (int m = 0; m < 4; ++m) {
                const int r = row0 + ai * 128 + m * 16; const float rstd = tabA(lds, u.pm, r);
#pragma unroll
                for (int bj = 0; bj < 2; ++bj) { const int c0 = col0 + bj * 128, w = c0 % 96;
                    f32x4 v0 = acc[ai][bj][m][0] * rstd, v1 = acc[ai][bj][m][1] * rstd;
                    f32x4 t0 = (f32x4){1.f, 0.f, 1.f, 0.f}, t1 = t0;
                    if (w >= 64) { const f32x4* tp = (const f32x4*)(rope + (size_t)(r & (SEQ - 1)) * 16 + ((w - 64) >> 1)); t0 = tp[0]; t1 = tp[1]; }
                    rot8(v0, v1, t0, t1);
                    *(u32x4*)(Q + (size_t)r * NQ + c0) = pack8(v0, v1); }
            }
    }
};
struct EpiKV {
    static constexpr bool PERM = true;
    bf16_t* KV; LAS unsigned char* lds;
    __device__ __forceinline__ void operator()(AccRef acc, const pg8::Unit& u, int wr, int wc, int fr, int fq) const {
        const int row0 = u.pm * 256 + wr * 64 + fr, col0 = u.pn * 256 + wc * 32 + 8 * fq;
#pragma unroll
        for (int ai = 0; ai < 2; ++ai)
#pragma unroll
            for (int m = 0; m < 4; ++m) {
                const int r = row0 + ai * 128 + m * 16; const float rstd = tabB(lds, u.pm, r);
#pragma unroll
                for (int bj = 0; bj < 2; ++bj)
                    *(u32x4*)(KV + (size_t)r * NKV + col0 + bj * 128) = pack8(acc[ai][bj][m][0] * rstd, acc[ai][bj][m][1] * rstd);
            }
    }
};

struct AttnT { const bf16_t* qmla; const bf16_t* kv; const bf16_t* proj; bf16_t* o; float* po; const float* bias; const float* sinks; };

template <bool SWA>
__device__ __forceinline__ void attn_unit(LAS unsigned char* lds, int b, int h, int qb, const AttnT& T, bool have) {
    constexpr int DQK = SWA ? 64 : 96, NS = DQK / 32, KP = DQK * 2 + 16, VP = 160;
    constexpr int KBUF = 16384, VOFF = 32768, VBUF = 16384, BIASOFF = 65536;
    const int tid = threadIdx.x, lane = tid & 63, wid = __builtin_amdgcn_readfirstlane(tid >> 6), l15 = lane & 15, g = lane >> 4;
    const int Q0 = SWA ? qb * 64 : qb * 256, q0w = SWA ? Q0 + 32 * (wid & 1) : Q0 + 32 * wid, hw = SWA ? 4 * h + (wid >> 1) : h;
    const size_t tok0 = (size_t)b * SEQ;
    bf16x8 Qf[2][NS];
#pragma unroll
    for (int sb = 0; sb < 2; ++sb)
#pragma unroll
        for (int s = 0; s < NS; ++s) {
            const size_t row = tok0 + q0w + 16 * sb + l15;
            const bf16_t* p = SWA ? T.proj + row * NPROJ + PC_QS + 64 * hw + 32 * s + 8 * g : T.qmla + row * NQ + 96 * h + 32 * s + 8 * g;
            Qf[sb][s] = *(const bf16x8*)p;
        }
    f32x4 negm[2], lacc[2], oT[2][4];
    const bf16x8 ones = (bf16x8){0x3F80, 0x3F80, 0x3F80, 0x3F80, 0x3F80, 0x3F80, 0x3F80, 0x3F80};
#pragma unroll
    for (int sb = 0; sb < 2; ++sb) {
        if (SWA) { const float ms = -T.sinks[hw] * LOG2E; negm[sb] = (f32x4){ms, ms, ms, ms}; lacc[sb] = (f32x4){1.f, 1.f, 1.f, 1.f}; } else { negm[sb] = (f32x4){0.f, 0.f, 0.f, 0.f}; lacc[sb] = negm[sb]; }
#pragma unroll
        for (int c = 0; c < 4; ++c) oT[sb][c] = (f32x4){0.f, 0.f, 0.f, 0.f};
    }
    const int kbase = SWA ? Q0 - 128 : 0, j0 = SWA ? (Q0 < 128 ? (128 - Q0) / 64 : 0) : 0, NT = SWA ? 3 : 4 * (qb + 1);
    const int skey = tid >> 3, sch = tid & 7;
    const bf16_t* ksrc; const bf16_t* vsrc; const bf16_t* pesrc = nullptr; size_t kpitch;
    if (SWA) { const int kvh = h; ksrc = T.proj + (tok0 + skey) * NPROJ + PC_KS + 64 * kvh + 8 * sch; vsrc = ksrc + (PC_VS - PC_KS); kpitch = NPROJ; }
    else { ksrc = T.kv + (tok0 + skey) * NKV + 128 * h + 8 * sch; vsrc = ksrc + 64; kpitch = NKV; pesrc = T.proj + (tok0 + (tid >> 2)) * NPROJ + PC_KPE + 8 * (tid & 3); }
    const int kdst = skey * KP + 16 * sch, vdst = VOFF + skey * VP + 16 * sch, pedst = (tid >> 2) * KP + 128 + 16 * (tid & 3);
    if (SWA && !have) { for (int e = tid; e < 4 * 320; e += 512) { const int hl = e / 320, x = e % 320, d = 223 - x;
            *(LAS float*)(lds + BIASOFF + 4 * e) = ((unsigned)d < 128u) ? T.bias[(4 * h + hl) * 128 + d] : -1e30f; } }
    u32x4 rk, rv, rpe = (u32x4){0u, 0u, 0u, 0u};
#define AT_LOAD(j) do { const size_t k0_ = (size_t)(kbase + 64 * (j)); rk = *(const u32x4*)(ksrc + k0_ * kpitch); rv = *(const u32x4*)(vsrc + k0_ * kpitch); \
        if (!SWA) { if (tid < 256) rpe = *(const u32x4*)(pesrc + k0_ * NPROJ); } } while (0)
#define AT_STORE(bi) do { *(LAS u32x4*)(lds + (bi) * KBUF + kdst) = rk; *(LAS u32x4*)(lds + (bi) * VBUF + vdst) = rv; \
        if (!SWA) { if (tid < 256) *(LAS u32x4*)(lds + (bi) * KBUF + pedst) = rpe; } } while (0)
    AT_LOAD(j0); AT_STORE(0);
    if (j0 + 1 < NT) AT_LOAD(j0 + 1);
    __syncthreads();
    for (int j = j0; j < NT; ++j) {
        const bool more = j + 1 < NT; const int bi = (j - j0) & 1; const int k0 = kbase + 64 * j;
        if (more) AT_STORE(bi ^ 1);
        if (j + 2 < NT) AT_LOAD(j + 2);
        const bool active = SWA ? (k0 + 63 >= q0w - 127 && k0 <= q0w + 31) : (k0 <= q0w + 31);
        if (active) {
            const LAS unsigned char* Kb = lds + bi * KBUF; const LAS unsigned char* Vb = lds + VOFF + bi * VBUF;
            f32x4 sT[2][4];
#pragma unroll
            for (int kb = 0; kb < 4; ++kb) {
                const int rowk = 16 * kb + l15;
                sT[0][kb] = negm[0]; sT[1][kb] = negm[1];
#pragma unroll
                for (int s = 0; s < NS; ++s) {
                    const bf16x8 Kf = *(const LAS bf16x8*)(Kb + rowk * KP + (32 * s + 8 * g) * 2);
                    sT[0][kb] = __builtin_amdgcn_mfma_f32_16x16x32_bf16(Kf, Qf[0][s], sT[0][kb], 0, 0, 0);
                    sT[1][kb] = __builtin_amdgcn_mfma_f32_16x16x32_bf16(Kf, Qf[1][s], sT[1][kb], 0, 0, 0);
                }
            }
            const bool need_mask = SWA ? true : (k0 + 63 > q0w);
            u32x4 pw[2][2];
#pragma unroll
            for (int sb = 0; sb < 2; ++sb) {
                const int q = q0w + 16 * sb + l15;
                if (SWA) {
                    const LAS float* bt = (const LAS float*)(lds + BIASOFF) + (wid >> 1) * 320 + (223 - q + k0 + 4 * g);
#pragma unroll
                    for (int kb = 0; kb < 4; ++kb)
#pragma unroll
                        for (int i = 0; i < 4; ++i) sT[sb][kb][i] += bt[16 * kb + i];
                } else if (need_mask) {
#pragma unroll
                    for (int kb = 0; kb < 4; ++kb)
#pragma unroll
                        for (int i = 0; i < 4; ++i) { const int key = k0 + 16 * kb + 4 * g + i; if (key > q) sT[sb][kb][i] = -1e30f; }
                }
                const bool first = (!SWA) && (j == 0);
                if (first || (SWA ? (j == j0) : ((j & 7) == 0))) {
                float mx = fmaxf(fmaxf(sT[sb][0][0], sT[sb][0][1]), sT[sb][0][2]);
                mx = fmaxf(fmaxf(mx, sT[sb][0][3]), sT[sb][1][0]); mx = fmaxf(fmaxf(mx, sT[sb][1][1]), sT[sb][1][2]); mx = fmaxf(fmaxf(mx, sT[sb][1][3]), sT[sb][2][0]);
                mx = fmaxf(fmaxf(mx, sT[sb][2][1]), sT[sb][2][2]); mx = fmaxf(fmaxf(mx, sT[sb][2][3]), sT[sb][3][0]); mx = fmaxf(fmaxf(mx, sT[sb][3][1]), sT[sb][3][2]);
                mx = fmaxf(mx, sT[sb][3][3]);
                mx = quad_max(mx);
                if (first || __any(mx > 6.f)) {
                    const float delta = first ? mx : fmaxf(mx, 0.f); negm[sb] = negm[sb] - delta;
                    if (!first) { const float alpha = __builtin_amdgcn_exp2f(-delta); lacc[sb] = lacc[sb] * alpha;
#pragma unroll
                        for (int c = 0; c < 4; ++c) oT[sb][c] = oT[sb][c] * alpha; }
#pragma unroll
                    for (int kb = 0; kb < 4; ++kb) sT[sb][kb] = sT[sb][kb] - delta;
                }
                }
#pragma unroll
                for (int kb = 0; kb < 4; ++kb)
#pragma unroll
                    for (int i = 0; i < 4; ++i) sT[sb][kb][i] = __builtin_amdgcn_exp2f(sT[sb][kb][i]);
#pragma unroll
                for (int ks = 0; ks < 2; ++ks) pw[sb][ks] = pack8(sT[sb][2 * ks], sT[sb][2 * ks + 1]);
            }
#pragma unroll
            for (int ks = 0; ks < 2; ++ks) {
                const bf16x8 P0 = __builtin_bit_cast(bf16x8, pw[0][ks]), P1 = __builtin_bit_cast(bf16x8, pw[1][ks]);
                lacc[0] = __builtin_amdgcn_mfma_f32_16x16x32_bf16(ones, P0, lacc[0], 0, 0, 0); lacc[1] = __builtin_amdgcn_mfma_f32_16x16x32_bf16(ones, P1, lacc[1], 0, 0, 0);
#pragma unroll
                for (int c = 0; c < 4; ++c) {
                    const LAS unsigned char* ta = Vb + (32 * ks + 4 * g + (l15 >> 2)) * VP + (16 * c + 4 * (lane & 3)) * 2;
                    const s16x4 lo = __builtin_amdgcn_ds_read_tr16_b64_v4i16((LAS s16x4*)ta);
                    const s16x4 hi = __builtin_amdgcn_ds_read_tr16_b64_v4i16((LAS s16x4*)(ta + 16 * VP));
                    const bf16x8 Vf = (bf16x8){lo[0], lo[1], lo[2], lo[3], hi[0], hi[1], hi[2], hi[3]};
                    oT[0][c] = __builtin_amdgcn_mfma_f32_16x16x32_bf16(Vf, P0, oT[0][c], 0, 0, 0);
                    oT[1][c] = __builtin_amdgcn_mfma_f32_16x16x32_bf16(Vf, P1, oT[1][c], 0, 0, 0);
                }
            }
        }
        asm volatile("s_waitcnt lgkmcnt(0)" ::: "memory");
        __builtin_amdgcn_s_barrier();
        asm volatile("" ::: "memory");
    }
#undef AT_LOAD
#undef AT_STORE
#pragma unroll
    for (int sb = 0; sb < 2; ++sb) {
        const float inv = 1.0f / lacc[sb][0];
        const size_t row = tok0 + q0w + 16 * sb + l15; float ss = 0.f;
        u32x2 w[4];
#pragma unroll
        for (int c = 0; c < 4; ++c) { const f32x4 v = oT[sb][c] * inv; ss += sq4(v); w[c].x = cvt_pk_bf16(v[0], v[1]); w[c].y = cvt_pk_bf16(v[2], v[3]); }
#pragma unroll
        for (int c = 0; c < 4; c += 2) {
            auto sx = __builtin_amdgcn_permlane16_swap(w[c].x, w[c + 1].x, false, false); auto sy = __builtin_amdgcn_permlane16_swap(w[c].y, w[c + 1].y, false, false);
            const u32x4 o = (u32x4){sx[0], sy[0], sx[1], sy[1]};
            const int col = (g & 1) ? 16 * (c + 1) + 4 * (g - 1) : 16 * c + 4 * g;
            *(u32x4*)(T.o + row * DM + (SWA ? 512 : 0) + 64 * hw + col) = o;
        }
        ss = quad_sum(ss);
        if (g == 0) T.po[row * 16 + (SWA ? 8 : 0) + hw] = ss;
    }
}


#if defined(DBG_NAIVE_SWA)
__device__ __forceinline__ float bf2f(bf16_t v) { return __builtin_bit_cast(float, (unsigned)v << 16); }
__device__ __forceinline__ void naive_swa(const AttnT& T, int gt, int NGT) {
    for (int idx = gt; idx < MTOK * 8; idx += NGT) {
        const int t = idx >> 3, hq = idx & 7, s = t & (SEQ - 1), kvh = hq >> 2;
        float q[64], o[64];
#pragma unroll
        for (int d = 0; d < 64; ++d) { q[d] = bf2f(T.proj[(size_t)t * NPROJ + PC_QS + 64 * hq + d]); o[d] = 0.f; }
        float m = T.sinks[hq] * LOG2E, l = 1.f;
        const int klo = s - 127 < 0 ? 0 : s - 127;
        for (int k = klo; k <= s; ++k) {
            const size_t kr = (size_t)(t - s + k) * NPROJ;
            float sc = 0.f;
#pragma unroll
            for (int d = 0; d < 64; ++d) sc += q[d] * bf2f(T.proj[kr + PC_KS + 64 * kvh + d]);
            sc += T.bias[hq * 128 + (s - k)];
            const float mn = fmaxf(m, sc), al = exp2f(m - mn), p = exp2f(sc - mn); m = mn; l = l * al + p;
#pragma unroll
            for (int d = 0; d < 64; ++d) o[d] = o[d] * al + p * bf2f(T.proj[kr + PC_VS + 64 * kvh + d]);
        }
        float ss = 0.f; const float inv = 1.f / l;
#pragma unroll
        for (int d = 0; d < 64; d += 2) { const float a = o[d] * inv, b = o[d + 1] * inv; ss += a * a + b * b; *(unsigned*)(T.o + (size_t)t * DM + 512 + 64 * hq + d) = cvt_pk_bf16(a, b); }
        T.po[(size_t)t * 16 + 8 + hq] = ss;
    }
}
#endif


#if defined(DBG_NAIVE_PROJ)
__device__ __forceinline__ float bf2f_(bf16_t v) { return __builtin_bit_cast(float, (unsigned)v << 16); }
__device__ __forceinline__ void naive_proj_swa(const bf16_t* HB, const float* stats, const float* gmix, const float* win, bf16_t* proj, int gt, int NGT) {
    for (int idx = gt; idx < MTOK * 768; idx += NGT) {
        const int t = idx / 768, j = idx % 768, n = 416 + j;
        float ssum = 0.f;
        for (int i = 0; i < 16; ++i) ssum += stats[(size_t)t * 16 + i];
        const float rstd = 1.0f / sqrtf(ssum * (1.0f / DM) + EPS);
        float acc = 0.f;
        for (int k = 0; k < DM; ++k) acc += bf2f_(HB[(size_t)t * DM + k]) * (gmix[k] * win[(size_t)k * 1184 + n]);
        const float val = acc * rstd * (j < 512 ? 0.125f * LOG2E : 1.0f);
        const int dest = j < 512 ? PC_QS + j : (j < 640 ? PC_KS + (j - 512) : PC_VS + (j - 640));
        proj[(size_t)t * NPROJ + dest] = (bf16_t)(cvt_pk_bf16(val, 0.f) & 0xffffu);
    }
}
#endif

#define RLX_AGENT __ATOMIC_RELAXED, __HIP_MEMORY_SCOPE_AGENT
#define XB_TMO      128
#define XB_XCNT(j)  (256  + 64 * (j))
#define XB_XSUB(j)  (1280 + 64 * (j))
#define XB_XGEN(j)  (2304 + 64 * (j))
#define XB_TOP      3328
#define XB_TOPGEN   3392
#define XCD_BAR_WORDS 3456
#define XB_SPIN_CAP (1u << 18)

__device__ __forceinline__ unsigned xb_ld(unsigned* p)              { return __hip_atomic_load(p, __ATOMIC_RELAXED, __HIP_MEMORY_SCOPE_AGENT); }
__device__ __forceinline__ unsigned xb_add(unsigned* p, unsigned v) { return __hip_atomic_fetch_add(p, v, __ATOMIC_RELAXED, __HIP_MEMORY_SCOPE_AGENT); }
__device__ __forceinline__ unsigned xb_xcc_id() { return (unsigned)__builtin_amdgcn_s_getreg((3 << 11) | 20) & 0xFu; }
#define XB_SPIN(cond, bar) do { unsigned _sp = 0; while (cond) { __builtin_amdgcn_s_sleep(1); \
    if ((++_sp & 255u) == 0u) { if (xb_ld(&(bar)[XB_TMO])) break; if (_sp > XB_SPIN_CAP) { atomicAdd(&(bar)[XB_TMO], 1u); break; } } } } while (0)

struct XcdBarrier {
    unsigned* bar; unsigned x;
    volatile LAS unsigned* st;
};

__device__ __forceinline__ XcdBarrier xcd_barrier_post(unsigned* bar, volatile LAS unsigned* st) {
    XcdBarrier b; b.bar = bar; b.x = xb_xcc_id(); b.st = st;
    if (threadIdx.x == 0) (void)xb_add(&bar[XB_XCNT(b.x)], 1u);
    return b;
}
__device__ __forceinline__ void xcd_barrier_complete(unsigned* bar, unsigned x, unsigned& nloc, unsigned& nx) {
    const unsigned G = gridDim.x * gridDim.y * gridDim.z;
    unsigned sum, cnt, mine, sp = 0u;
    for (;;) {
        sum = 0u; cnt = 0u; mine = 0u;
#pragma unroll
        for (unsigned j = 0; j < 16; ++j) { const unsigned c = xb_ld(&bar[XB_XCNT(j)]); sum += c; cnt += (c > 0u) ? 1u : 0u; mine = (j == x) ? c : mine; }
        if (sum == G) break;
        __builtin_amdgcn_s_sleep(1);
        if ((++sp & 255u) == 0u) { if (xb_ld(&bar[XB_TMO])) break; if (sp > XB_SPIN_CAP) { atomicAdd(&bar[XB_TMO], 1u); break; } }
    }
    nloc = mine > 0u ? mine : 1u; nx = cnt > 0u ? cnt : 1u;
}

__device__ __forceinline__ void xcd_barrier(const XcdBarrier& b) {
    asm volatile("s_waitcnt vmcnt(0)" ::: "memory");
    __syncthreads();
    if (threadIdx.x == 0) {
        unsigned* bar = b.bar;
        __builtin_amdgcn_s_waitcnt(0);
        unsigned nloc = b.st[0], nx = b.st[1];
        if (nloc == 0u) { xcd_barrier_complete(bar, b.x, nloc, nx); b.st[0] = nloc; b.st[1] = nx; }
        const unsigned old = xb_add(&bar[XB_XSUB(b.x)], 1u);
        const unsigned gen = old / nloc;
        if (old + 1u == (gen + 1u) * nloc) {
            __builtin_amdgcn_fence(__ATOMIC_RELEASE, "agent");
            asm volatile("s_waitcnt vmcnt(0)" ::: "memory");
            const unsigned og = xb_add(&bar[XB_TOP], 1u);
            const unsigned tg = og / nx;
            if (og + 1u == (tg + 1u) * nx) xb_add(&bar[XB_TOPGEN], 1u);
            else XB_SPIN(xb_ld(&bar[XB_TOPGEN]) == tg, bar);
            __builtin_amdgcn_fence(__ATOMIC_ACQUIRE, "agent");
            xb_add(&bar[XB_XGEN(b.x)], 1u);
            asm volatile("s_waitcnt vmcnt(0)" ::: "memory");
        } else {
            XB_SPIN(xb_ld(&bar[XB_XGEN(b.x)]) == gen, bar);
            __builtin_amdgcn_fence(__ATOMIC_ACQUIRE, "agent");
            asm volatile("s_waitcnt vmcnt(0)" ::: "memory");
        }
    }
    __syncthreads();
}

__device__ __forceinline__ unsigned f2bf(float f) { unsigned u = __builtin_bit_cast(unsigned, f); return (u + 0x7fffu + ((u >> 16) & 1u)) >> 16; }
__device__ __forceinline__ unsigned pk2(float lo, float hi) { return cvt_pk_bf16(lo, hi); }
enum MatId { ID_GATE = 0, ID_UP, ID_PLAIN, ID_IN, ID_QB };
__device__ __forceinline__ int rope_il(int i) { return i < 16 ? 2 * i : 2 * (i - 16) + 1; }
__device__ __forceinline__ void map_dest(int id, int n, int& row, float& sc) {
    sc = 1.f;
    if (id == ID_GATE) row = 256 * (n >> 7) + (n & 127);
    else if (id == ID_UP) row = 256 * (n >> 7) + 128 + (n & 127);
    else if (id == ID_IN) {
        if (n < 384) row = n;
        else if (n < 416) row = PC_KPE + rope_il(n - 384);
        else if (n < 928) { row = n - 416 + PC_QS; sc = 0.125f * LOG2E; }
        else if (n < 1056) row = n - 928 + PC_KS;
        else row = n - 1056 + PC_VS;
    } else if (id == ID_QB) { const int hh = n / 96, w = n % 96; row = (w < 64) ? n : 96 * hh + 64 + rope_il(w - 64); }
    else row = n;
}
struct P0Item { const float* W; int K, N; bf16_t* WT; int id; const float* ks; const float* ks2; int ksplit; int item; };
__device__ __forceinline__ void p0_item_load(const P0Item& d, float (&r)[32], int lane) {
    const int nblk = d.N / 32, kb = d.item / nblk, nb = d.item % nblk, k0 = 64 * kb, n0 = 32 * nb;
#pragma unroll
    for (int i = 0; i < 32; ++i) { const int kg = k0 + 2 * i + (lane >> 5); r[i] = d.W[(size_t)kg * d.N + n0 + (lane & 31)]; }
}
__device__ __forceinline__ void p0_item_finish(const P0Item& d, const float (&r)[32], LAS float* scr, int lane) {
    const int nblk = d.N / 32, kb = d.item / nblk, nb = d.item % nblk, k0 = 64 * kb, n0 = 32 * nb;
#pragma unroll
    for (int i = 0; i < 32; ++i) { const int kk = 2 * i + (lane >> 5), kg = k0 + kk; float v = r[i];
        if (d.ks) v *= (kg < d.ksplit) ? d.ks[kg] : d.ks2[kg - d.ksplit];
        scr[kk * 33 + (lane & 31)] = v; }
    asm volatile("s_waitcnt lgkmcnt(0)" ::: "memory");
    const int c = lane & 7;
#pragma unroll
    for (int j = 0; j < 4; ++j) { const int n = (lane >> 3) + 8 * j; const LAS float* sp = scr + (8 * c) * 33 + n; int drow; float sc; map_dest(d.id, n0 + n, drow, sc);
        u32x4 o; o.x = pk2(sp[0 * 33] * sc, sp[1 * 33] * sc); o.y = pk2(sp[2 * 33] * sc, sp[3 * 33] * sc); o.z = pk2(sp[4 * 33] * sc, sp[5 * 33] * sc); o.w = pk2(sp[6 * 33] * sc, sp[7 * 33] * sc);
        *(u32x4*)(d.WT + (size_t)drow * d.K + k0 + 8 * c) = o; }
    asm volatile("s_waitcnt lgkmcnt(0)" ::: "memory");
}
__device__ __forceinline__ void sincos_acc(float angf, float& c, float& s) {
    const double a = (double)angf; const double kq = rint(a * 0.63661977236758134); const double r = a - kq * 1.5707963267948966; const int q = ((int)kq) & 3; const double r2 = r * r;
    const double sp = r * (1.0 + r2 * (-1.0 / 6 + r2 * (1.0 / 120 + r2 * (-1.0 / 5040 + r2 * (1.0 / 362880 + r2 * (-1.0 / 39916800 + r2 * (1.0 / 6227020800.0)))))));
    const double cp = 1.0 + r2 * (-0.5 + r2 * (1.0 / 24 + r2 * (-1.0 / 720 + r2 * (1.0 / 40320 + r2 * (-1.0 / 3628800 + r2 * (1.0 / 479001600.0))))));
    const double sv = (q == 0) ? sp : (q == 1) ? cp : (q == 2) ? -sp : -cp, cv = (q == 0) ? cp : (q == 1) ? -sp : (q == 2) ? -cp : sp;
    c = (float)cv; s = (float)sv;
}

struct Args { const float* in[21]; float* out; unsigned char* ws; int ph_lo, ph_hi; };
constexpr int NPHASE = 9;

__global__ void __launch_bounds__(512, 2) mk_fwd(Args a) {
    extern __shared__ __attribute__((aligned(16))) unsigned char lds_raw[];
    LAS unsigned char* lds = (LAS unsigned char*)lds_raw;
    cg::grid_group grid = cg::this_grid();
    const int tid = threadIdx.x, lane = tid & 63, wave = __builtin_amdgcn_readfirstlane(tid >> 6);
    const int G = gridDim.x, bx = blockIdx.x;
    unsigned char* ws = a.ws;
    const float* x = a.in[0];
    f32x2* rope = (f32x2*)(ws + WS_ROPE); float* biasT = (float*)(ws + WS_BIAS);
    float* stats = (float*)(ws + WS_STATS); float* pq = (float*)(ws + WS_PQ); float* pkv = (float*)(ws + WS_PKV); float* po = (float*)(ws + WS_PO);
    bf16_t *W1gu = (bf16_t*)(ws + WS_W1GU), *W1d = (bf16_t*)(ws + WS_W1D), *W2gu = (bf16_t*)(ws + WS_W2GU), *W2d = (bf16_t*)(ws + WS_W2D);
    bf16_t *Win = (bf16_t*)(ws + WS_WIN), *Wqb = (bf16_t*)(ws + WS_WQB), *Wkvb = (bf16_t*)(ws + WS_WKVB), *Wo = (bf16_t*)(ws + WS_WO);
    bf16_t *hid = (bf16_t*)(ws + WS_HID), *proj = (bf16_t*)(ws + WS_PROJ), *qmla = (bf16_t*)(ws + WS_QMLA), *kvb = (bf16_t*)(ws + WS_KV), *ob = (bf16_t*)(ws + WS_O), *HB = (bf16_t*)(ws + WS_HB);
    const int lo = a.ph_lo, hi = a.ph_hi;
    volatile LAS unsigned* bst = (volatile LAS unsigned*)(lds + 139264);
    if (tid < 2) bst[tid] = 0u;
    __syncthreads();
    XcdBarrier xbar = xcd_barrier_post((unsigned*)(ws + WS_BAR), bst);
#ifndef PH_MASK
#define PH_MASK 0x3ff
#endif
#define IN(k) (((PH_MASK >> (k)) & 1) && lo <= (k) && (k) < hi)
#define SEAM(k) do { if (IN(k) && IN((k) + 1)) { if ((k) == 0) grid.sync(); else xcd_barrier(xbar); } } while (0)

    if (IN(0)) {
        LAS float* scr = (LAS float*)(lds + wave * 16384);
        const int gw = bx * 8 + wave, NGW = G * 8;
        constexpr int I_GU = (DM / 64) * (DFF / 32), I_D = (DFF / 64) * (DM / 32), I_IN = (DM / 64) * (1184 / 32), I_QB = (256 / 64) * (NQ / 32), I_KVB = (128 / 64) * (NKV / 32), I_O = (DM / 64) * (DM / 32);
        constexpr int NITEMS = 4 * I_GU + 2 * I_D + I_IN + I_QB + I_KVB + I_O;
#define P0_DECODE(it_, d_) do { int r = (it_); \
            if (r < I_GU) { d_ = P0Item{a.in[2], DM, DFF, W1gu, ID_GATE, a.in[1], a.in[1], DM, r}; break; } r -= I_GU; \
            if (r < I_GU) { d_ = P0Item{a.in[3], DM, DFF, W1gu, ID_UP, a.in[1], a.in[1], DM, r}; break; } r -= I_GU; \
            if (r < I_GU) { d_ = P0Item{a.in[17], DM, DFF, W2gu, ID_GATE, a.in[16], a.in[16], DM, r}; break; } r -= I_GU; \
            if (r < I_GU) { d_ = P0Item{a.in[18], DM, DFF, W2gu, ID_UP, a.in[16], a.in[16], DM, r}; break; } r -= I_GU; \
            if (r < I_D) { d_ = P0Item{a.in[4], DFF, DM, W1d, ID_PLAIN, nullptr, nullptr, 0, r}; break; } r -= I_D; \
            if (r < I_D) { d_ = P0Item{a.in[19], DFF, DM, W2d, ID_PLAIN, nullptr, nullptr, 0, r}; break; } r -= I_D; \
            if (r < I_IN) { d_ = P0Item{a.in[6], DM, 1184, Win, ID_IN, a.in[5], a.in[5], DM, r}; break; } r -= I_IN; \
            if (r < I_QB) { d_ = P0Item{a.in[8], 256, NQ, Wqb, ID_QB, a.in[7], a.in[7], 256, r}; break; } r -= I_QB; \
            if (r < I_KVB) { d_ = P0Item{a.in[10], 128, NKV, Wkvb, ID_PLAIN, a.in[9], a.in[9], 128, r}; break; } r -= I_KVB; \
            d_ = P0Item{a.in[15], DM, DM, Wo, ID_PLAIN, a.in[13], a.in[14], 512, r}; } while (0)
        if (gw < NITEMS) {
            P0Item dc, dn; float rc[32], rn[32];
            P0_DECODE(gw, dc); p0_item_load(dc, rc, lane);
            for (int it = gw; it < NITEMS; it += NGW) {
                const bool hn = it + NGW < NITEMS;
                if (hn) { P0_DECODE(it + NGW, dn); p0_item_load(dn, rn, lane); }
                p0_item_finish(dc, rc, scr, lane);
                if (hn) { dc = dn;
#pragma unroll
                    for (int i = 0; i < 32; ++i) rc[i] = rn[i]; }
            }
        }
#undef P0_DECODE
        const int gt = bx * 512 + tid, NGT = G * 512;
        for (int i = gt; i < 96 * DM / 8; i += NGT) ((u32x4*)(Win + (size_t)416 * DM))[i] = (u32x4){0u, 0u, 0u, 0u};
#if defined(DBG_NAIVE_WIN)
        __syncthreads();
        if (bx == 0) { asm volatile("s_waitcnt vmcnt(0)" ::: "memory"); }
#endif
        for (int i = gt; i < SEQ * 16; i += NGT) { const int pos = i >> 4, k = i & 15; const float inv = exp2f(-(float)(2 * k) * (1.0f / 32.0f) * 13.287712379549449f);
            float c, s; sincos_acc((float)pos * inv, c, s); rope[i] = (f32x2){c, s}; }
#if defined(DBG_NAIVE_WIN)
        for (int i = gt; i < DM * 1184; i += NGT) { const int k = i / 1184, n = i % 1184; int drow; float sc; map_dest(ID_IN, n, drow, sc);
            Win[(size_t)drow * DM + k] = (bf16_t)f2bf(a.in[6][i] * a.in[5][k] * sc); }
#endif
        for (int i = gt; i < 8 * 128; i += NGT) { const int hh = i >> 7, d = i & 127; int bk = d;
            if (d >= 16) { bk = 16 + (int)(logf((float)d / 16.0f) / 2.0794415416798357f * 16.0f); if (bk > 31) bk = 31; }
            biasT[i] = a.in[12][bk * 8 + hh] * LOG2E; }
        for (int m = gw; m < MTOK; m += NGW) {
            const f32x4* xr = (const f32x4*)(x + (size_t)m * DM) + lane; f32x4 v[4]; float s = 0.f;
#pragma unroll
            for (int j = 0; j < 4; ++j) { v[j] = xr[64 * j]; s += sq4(v[j]); }
            s = wave_sum(s);
            unsigned long long* o8 = (unsigned long long*)(HB + (size_t)m * DM) + lane;
#pragma unroll
            for (int j = 0; j < 4; ++j) o8[64 * j] = (unsigned long long)cvt_pk_bf16(v[j].x, v[j].y) | ((unsigned long long)cvt_pk_bf16(v[j].z, v[j].w) << 32);
            if (lane < 16) stats[(size_t)m * 16 + lane] = (lane == 0) ? s : 0.f;
        }
        __syncthreads();
    }
    SEAM(0);
#define TAB_FILL(expr_a, expr_b) do { for (int idx = tid; idx < 1024; idx += 512) { const int r = tab_row(bx, idx); float va, vb; { expr_a; } { expr_b; } \
        *(LAS float*)(lds + TAB_OFF + 4 * idx) = va; *(LAS float*)(lds + TABB_OFF + 4 * idx) = vb; } __syncthreads(); } while (0)
#define SUM16(p) ({ const f32x4* q_ = (const f32x4*)((p) + (size_t)r * 16); sum4(q_[0]) + sum4(q_[1]) + sum4(q_[2]) + sum4(q_[3]); })
#define FFN_UP(Wgu) do { TAB_FILL(va = rsq(SUM16(stats) * (1.0f / DM) + EPS), vb = 0.f); \
        pg8::Gemm g{HB, Wgu, MTOK, 2 * DFF, DM, DM, DM}; pg8::StaticOrder S; S.init(MTOK, 2 * DFF, G, bx); EpiSwiGLU E{hid, lds}; \
        pg8::gemm_phase(lds, g, S, E, pg8::NoMid{}); } while (0)
    if (IN(1)) FFN_UP(W1gu);
    SEAM(1);
    if (IN(2)) { pg8::Gemm g{hid, W1d, MTOK, DM, DFF, DFF, DFF}; pg8::StaticOrder S; S.init(MTOK, DM, G, bx); EpiResid<false> E{HB, stats, 0.5f, lds};
        pg8::gemm_phase(lds, g, S, E, pg8::NoMid{}); }
    SEAM(2);
    if (IN(3)) { TAB_FILL(va = rsq(SUM16(stats) * (1.0f / DM) + EPS), vb = 0.f);
        pg8::Gemm g{HB, Win, MTOK, NPROJ, DM, DM, DM}; pg8::StaticOrder S; S.init(MTOK, NPROJ, G, bx); EpiProj E{proj, pq, pkv, rope, lds};
        pg8::gemm_phase(lds, g, S, E, pg8::NoMid{}); }
    SEAM(3);
    if (IN(4)) {
        TAB_FILL(va = rsq(sum4(*(const f32x4*)(pq + (size_t)r * 4)) * (1.0f / 256.0f) + EPS) * (0.10206207261596575f * LOG2E), vb = rsq(sum4(*(const f32x4*)(pkv + (size_t)r * 4)) * (1.0f / 128.0f) + EPS));
        { pg8::Gemm g{proj, Wqb, MTOK, NQ, 256, NPROJ, 256}; pg8::StaticOrder S; S.init(MTOK, NQ, G, bx); EpiQ E{qmla, rope, lds};
          pg8::gemm_phase(lds, g, S, E, pg8::NoMid{}); }
        { pg8::Gemm g{proj + 256, Wkvb, MTOK, NKV, 128, NPROJ, 128}; pg8::StaticOrder S; S.init(MTOK, NKV, G, bx); EpiKV E{kvb, lds};
          pg8::gemm_phase(lds, g, S, E, pg8::NoMid{}); }
    }
    SEAM(4);
    if (IN(5)) {
        const AttnT T{qmla, kvb, proj, ob, po, biasT, a.in[11]};
        for (int uu = bx; uu < 256; uu += G) {
            const int b = (uu & 7) * 4 + (uu >> 6), h = (uu >> 3) & 7;
            for (int qb = 7; qb >= 0; --qb) attn_unit<false>(lds, b, h, qb, T, false);
            for (int i = 0; i < 8; ++i) attn_unit<true>(lds, b, h >> 2, (h & 3) * 8 + i, T, i != 0);
        }
    }
    SEAM(5);
    if (IN(6)) {
        TAB_FILL(const f32x4* q_ = (const f32x4*)(po + (size_t)r * 16); const float mla_ = sum4(q_[0]) + sum4(q_[1]); const float swa_ = sum4(q_[2]) + sum4(q_[3]);
                 va = rsq(mla_ * (1.0f / 512.0f) + EPS) * sqrtf(swa_ * (1.0f / 512.0f) + EPS),
                 const f32x4* q2_ = (const f32x4*)(po + (size_t)r * 16); vb = rsq((sum4(q2_[2]) + sum4(q2_[3])) * (1.0f / 512.0f) + EPS));
        pg8::Gemm g{ob, Wo, MTOK, DM, DM, DM, DM}; pg8::StaticOrder S; S.init(MTOK, DM, G, bx); EpiResid<true> E{HB, stats, 1.0f, lds}; MidWo Md{lds};
        pg8::gemm_phase(lds, g, S, E, Md); }
    SEAM(6);
    if (IN(7)) FFN_UP(W2gu);
    SEAM(7);
    if (IN(8)) { pg8::Gemm g{hid, W2d, MTOK, DM, DFF, DFF, DFF}; pg8::StaticOrder S; S.init(MTOK, DM, G, bx);
        EpiFinal E{HB, stats, a.out, a.in[20], (unsigned*)(ws + WS_BAR + 16384), 0.5f};
        pg8::gemm_phase(lds, g, S, E, pg8::NoMid{}); }
#undef IN
#undef SEAM
}

extern "C" void kernel_launch(void* const* d_in, const int* in_sizes, int n_in, void* d_out, int out_size, void* d_ws, size_t ws_size, hipStream_t stream) {
    static int grid = 0;
    if (grid == 0) {
        if (n_in != 21 || out_size != MTOK * DM || ws_size < WS_END) { fprintf(stderr, "kernel_launch: unexpected shapes (n_in %d, out %d, ws %zu)\n", n_in, out_size, ws_size); grid = -1; return; }
        int dev = 0, cus = 0, per_cu = 0;
        hipGetDevice(&dev); hipDeviceGetAttribute(&cus, hipDeviceAttributeMultiprocessorCount, dev);
        if (hipFuncSetAttribute((const void*)mk_fwd, hipFuncAttributeMaxDynamicSharedMemorySize, LDS_BYTES) != hipSuccess) { fprintf(stderr, "kernel_launch: hipFuncSetAttribute failed\n"); grid = -1; return; }
        if (hipOccupancyMaxActiveBlocksPerMultiprocessor(&per_cu, (const void*)mk_fwd, 512, LDS_BYTES) != hipSuccess || per_cu < 1) { fprintf(stderr, "kernel_launch: occupancy query gave %d\n", per_cu); per_cu = 1; }
        (void)hipGetLastError();
        grid = cus * 1;
        if (grid > 256) grid = 256;
    }
    if (grid < 0) return;
    Args a{};
    for (int i = 0; i < 21; ++i) a.in[i] = (const float*)d_in[i];
    a.out = (float*)d_out; a.ws = (unsigned char*)d_ws;
    if (hipMemsetAsync((char*)d_ws + WS_BAR, 0, BAR_BYTES, stream) != hipSuccess) { fprintf(stderr, "kernel_launch: memset failed\n"); return; }
#if MK_ONE_LAUNCH
    a.ph_lo = 0; a.ph_hi = NPHASE;
    void* args[] = {&a};
    hipError_t e = hipLaunchCooperativeKernel((const void*)mk_fwd, dim3(grid), dim3(512), args, LDS_BYTES, stream);
    if (e != hipSuccess) fprintf(stderr, "cooperative launch failed: %s (grid %d)\n", hipGetErrorString(e), grid);
#else
    for (int p = 0; p < NPHASE; ++p) { a.ph_lo = p; a.ph_hi = p + 1; hipLaunchKernelGGL(mk_fwd, dim3(grid), dim3(512), LDS_BYTES, stream, a); }
#endif
}
```

```cpp
#include <hip/hip_runtime.h>
#include <hip/hip_cooperative_groups.h>
#include <cstdio>
#include <cstdint>
namespace cg = cooperative_groups;

#ifndef MK_ONE_LAUNCH
#define MK_ONE_LAUNCH 1
#endif

#define LAS __attribute__((address_space(3)))
typedef unsigned short bf16_t;
typedef short bf16x8 __attribute__((ext_vector_type(8)));
typedef short s16x4 __attribute__((ext_vector_type(4)));
typedef float f32x4 __attribute__((ext_vector_type(4)));
typedef float f32x2 __attribute__((ext_vector_type(2)));
typedef unsigned u32x4 __attribute__((ext_vector_type(4)));
typedef unsigned u32x2 __attribute__((ext_vector_type(2)));

constexpr int MTOK = 65536, DM = 1024, DFF = 2816, SEQ = 2048, NPROJ = 1280, NQ = 768, NKV = 1024;
constexpr float EPS = 1e-6f;
constexpr float LOG2E = 1.4426950408889634f;
constexpr int PC_KPE = 384, PC_QS = 512, PC_KS = 1024, PC_VS = 1152;

constexpr size_t MiB = 1u << 20;
constexpr size_t WS_ROPE = 0;
constexpr size_t WS_BIAS = 512 * 1024;
constexpr size_t WS_BAR = 1 * MiB, BAR_BYTES = 32768;
constexpr size_t WS_STATS = 4 * MiB;
constexpr size_t WS_PQ = 8 * MiB;
constexpr size_t WS_PKV = 9 * MiB;
constexpr size_t WS_PO = 10 * MiB;
constexpr size_t WS_W1GU = 16 * MiB, WS_W1D = 27 * MiB, WS_W2GU = 33 * MiB, WS_W2D = 44 * MiB, WS_WIN = 50 * MiB, WS_WQB = 53 * MiB, WS_WKVB = 54 * MiB, WS_WO = 55 * MiB;
constexpr size_t WS_HID = 64 * MiB;
constexpr size_t WS_PROJ = 64 * MiB;
constexpr size_t WS_QMLA = 224 * MiB;
constexpr size_t WS_KV = 416 * MiB;
constexpr size_t WS_O = 544 * MiB;
constexpr size_t WS_HB = 672 * MiB;
constexpr size_t WS_END = 800 * MiB;

constexpr int LDS_BYTES = 147456;

typedef __bf16 bf16x2_t __attribute__((ext_vector_type(2)));
__device__ __forceinline__ unsigned cvt_pk_bf16(float lo, float hi) { const f32x2 v = {lo, hi}; const bf16x2_t b = __builtin_convertvector(v, bf16x2_t); return __builtin_bit_cast(unsigned, b); }
__device__ __forceinline__ float wave_sum(float v) {
#pragma unroll
    for (int o = 1; o < 64; o <<= 1) v += __shfl_xor(v, o);
    return v;
}
__device__ __forceinline__ float sum4(f32x4 v) { return (v.x + v.y) + (v.z + v.w); }
__device__ __forceinline__ float sq4(f32x4 v) { return (v.x * v.x + v.y * v.y) + (v.z * v.z + v.w * v.w); }
__device__ __forceinline__ float quad_sum(float s) {
    auto a = __builtin_amdgcn_permlane16_swap(__float_as_uint(s), __float_as_uint(s), false, false); s = __uint_as_float(a[0]) + __uint_as_float(a[1]);
    auto b = __builtin_amdgcn_permlane32_swap(__float_as_uint(s), __float_as_uint(s), false, false); return __uint_as_float(b[0]) + __uint_as_float(b[1]);
}
__device__ __forceinline__ float quad_max(float s) {
    auto a = __builtin_amdgcn_permlane16_swap(__float_as_uint(s), __float_as_uint(s), false, false); s = fmaxf(__uint_as_float(a[0]), __uint_as_float(a[1]));
    auto b = __builtin_amdgcn_permlane32_swap(__float_as_uint(s), __float_as_uint(s), false, false); return fmaxf(__uint_as_float(b[0]), __uint_as_float(b[1]));
}
__device__ __forceinline__ float rsq(float x) { return __builtin_amdgcn_rsqf(x); }

namespace pg8 {
constexpr int BM = 256, BK = 64, HALF = 128, HTB = HALF * BK * 2, STAGE_BYTES = 8 * HTB, NXCD = 8, WGM = 8;
__host__ __device__ __forceinline__ int lds_byte(int r, int c) { const int st = (r >> 4) * 2 + (c >> 5), rr = r & 15, cc = c & 31, ob = rr * 64 + cc * 2; return st * 1024 + (ob ^ (((ob >> 9) & 1) << 5)); }
__host__ __device__ __forceinline__ void stage_rc(int b, int& R, int& C) { const int st = b / 1024, sb = b % 1024, swz = sb ^ (((sb >> 9) & 1) << 5); R = (st >> 1) * 16 + swz / 64; C = (st & 1) * 32 + (swz % 64) / 2; }
__host__ __device__ __forceinline__ int perm32(int rho) { const int n = rho >> 4, i = rho & 15; return 8 * (i >> 2) + 4 * n + (i & 3); }

struct Unit { int pm, pn; };
struct Gemm { const bf16_t* A; const bf16_t* Bt; int M, N, K, lda, ldb; };

struct StaticOrder {
    int nM, nN, nwg, G, c;
    __device__ void init(int M, int N, int G_, int c_) { nM = M / BM; nN = N / BM; nwg = nM * nN; G = G_; c = c_; }
    __device__ bool next(int i, Unit& u) const {
        const long L = (long)i * G + c; if (L >= nwg) return false;
        int wgid = (int)L; { const int q = nwg / NXCD, r = nwg % NXCD, xcd = wgid % NXCD, off = wgid / NXCD; wgid = (xcd < r ? xcd * (q + 1) : r * (q + 1) + (xcd - r) * q) + off; }
        const int nig = WGM * nN, gid = wgid / nig, fm = gid * WGM, gsz = (nM - fm) < WGM ? (nM - fm) : WGM;
        u.pm = fm + ((wgid % nig) % gsz); u.pn = (wgid % nig) / gsz; return true;
    }
};
struct NoMid { static constexpr bool ON = false; __device__ __forceinline__ void apply(f32x4 (&)[2][2][4][2], const Unit&, int, int, int) const {} };

template <class Epi, class Mid>
__device__ __forceinline__ void gemm_phase(LAS unsigned char* lds, const Gemm g, const StaticOrder& S, const Epi& E, const Mid& Md) {
    const int tid = threadIdx.x, wid = __builtin_amdgcn_readfirstlane(tid >> 6), lane = tid & 63, wr = wid >> 2, wc = wid & 3, fr = lane & 15, fq = lane >> 4;
    int K = g.K; asm volatile("" : "+s"(K)); const int nt = K / BK;
    unsigned voffA[2], voffB[2];
#pragma unroll
    for (int i = 0; i < 2; ++i) { int R, C; stage_rc(tid * 16 + i * 8192, R, C); const int Rb = Epi::PERM ? ((R & ~31) + perm32(R & 31)) : R;
        voffA[i] = (unsigned)(R * g.lda + C) * 2u; voffB[i] = (unsigned)(Rb * g.ldb + C) * 2u; }
    const size_t kstep = (size_t)(BK * 2);
    const size_t hsA = (size_t)HALF * g.lda * 2, hsB = (size_t)HALF * g.ldb * 2, tsA = 2 * hsA, tsB = 2 * hsB;
    const unsigned ldsw = (unsigned)wid * 1024u;
    const int aoff = lds_byte(wr * 64 + fr, fq * 8), boff = lds_byte(wc * 32 + fr, fq * 8);
#define PG8_SA(b, h) (((b) * 2 + (h)) * HTB)
#define PG8_SB(b, h) ((4 + (b) * 2 + (h)) * HTB)
#define PG8_STAGE(bufoff, gbase, voff) do { _Pragma("unroll") for (int _i = 0; _i < 2; ++_i) \
        __builtin_amdgcn_global_load_lds((const unsigned*)((const char*)(gbase) + (voff)[_i]), (LAS unsigned*)(lds + (bufoff) + ldsw + _i * 8192), 16, 0, 0); } while (0)
#define PG8_LDA(dst, b, h) do { _Pragma("unroll") for (int m = 0; m < 4; ++m) _Pragma("unroll") for (int k = 0; k < 2; ++k) dst[m][k] = *(const LAS bf16x8*)(lds + PG8_SA(b, h) + aoff + m * 2048 + k * 1024); } while (0)
#define PG8_LDB(dst, b, h) do { _Pragma("unroll") for (int n = 0; n < 2; ++n) _Pragma("unroll") for (int k = 0; k < 2; ++k) dst[n][k] = *(const LAS bf16x8*)(lds + PG8_SB(b, h) + boff + n * 2048 + k * 1024); } while (0)
#define PG8_MMA(ai, bj, At, Bt) do { __builtin_amdgcn_s_setprio(1); _Pragma("unroll") for (int m = 0; m < 4; ++m) _Pragma("unroll") for (int n = 0; n < 2; ++n) _Pragma("unroll") for (int k = 0; k < 2; ++k) \
        acc[ai][bj][m][n] = __builtin_amdgcn_mfma_f32_16x16x32_bf16(Bt[n][k], At[m][k], acc[ai][bj][m][n], 0, 0, 0); __builtin_amdgcn_s_setprio(0); } while (0)
#define PG8_WAIT_V(n) asm volatile("s_waitcnt vmcnt(" #n ")" ::: "memory")
#define PG8_WAIT_L(n) asm volatile("s_waitcnt lgkmcnt(" #n ")" ::: "memory")
#define PG8_BAR __builtin_amdgcn_s_barrier()
#define PG8_SCHED __builtin_amdgcn_sched_barrier(0)
    Unit cur, nxt; int ui = 0;
    if (!S.next(0, cur)) return;
    f32x4 acc[2][2][4][2];
#pragma unroll
    for (int a = 0; a < 2; ++a)
#pragma unroll
        for (int b = 0; b < 2; ++b)
#pragma unroll
            for (int m = 0; m < 4; ++m)
#pragma unroll
                for (int n = 0; n < 2; ++n) acc[a][b][m][n] = (f32x4){0.f, 0.f, 0.f, 0.f};
    bf16x8 At[4][2], B0[2][2], B1[2][2];
    const char* cA = (const char*)g.A + (size_t)cur.pm * tsA; const char* cB = (const char*)g.Bt + (size_t)cur.pn * tsB;
    PG8_STAGE(PG8_SB(0, 0), cB, voffB); PG8_STAGE(PG8_SB(0, 1), cB + hsB, voffB); PG8_STAGE(PG8_SA(0, 0), cA, voffA); PG8_STAGE(PG8_SA(0, 1), cA + hsA, voffA);
    if (wr == 1) PG8_BAR;
    PG8_WAIT_V(2); PG8_BAR;
    PG8_STAGE(PG8_SB(1, 0), cB + kstep, voffB); PG8_STAGE(PG8_SA(1, 0), cA + kstep, voffA); PG8_STAGE(PG8_SB(1, 1), cB + hsB + kstep, voffB);
    PG8_WAIT_V(6); PG8_BAR;
    for (;;) {
        const bool has_next = S.next(ui + 1, nxt);
        const char* nA = has_next ? (const char*)g.A + (size_t)nxt.pm * tsA : cA; const char* nB = has_next ? (const char*)g.Bt + (size_t)nxt.pn * tsB : cB;
        for (int t = 0; t < nt; t += 2) {
            const bool last = (t == nt - 2);
            const char* a1 = cA + (size_t)(t + 1) * kstep;
            const char* a2 = last ? nA : cA + (size_t)(t + 2) * kstep; const char* b2 = last ? nB : cB + (size_t)(t + 2) * kstep;
            const char* a3 = a2 + kstep; const char* b3 = b2 + kstep;
            if constexpr (Mid::ON) { if (t * 2 == nt && t != 0) Md.apply(acc, cur, wr, fr, fq); }
            PG8_LDB(B0, 0, 0); PG8_LDB(B1, 0, 1); PG8_SCHED; PG8_LDA(At, 0, 0); PG8_STAGE(PG8_SA(1, 1), a1 + hsA, voffA);
            PG8_WAIT_V(8); PG8_WAIT_L(0); PG8_BAR; PG8_MMA(0, 0, At, B0); PG8_MMA(0, 1, At, B1); PG8_BAR; PG8_SCHED;
            PG8_LDA(At, 0, 1); PG8_STAGE(PG8_SB(0, 0), b2, voffB); PG8_STAGE(PG8_SB(0, 1), b2 + hsB, voffB); PG8_STAGE(PG8_SA(0, 0), a2, voffA);
            PG8_WAIT_V(8); PG8_WAIT_L(0); PG8_BAR; PG8_MMA(1, 0, At, B0); PG8_MMA(1, 1, At, B1); PG8_BAR; PG8_SCHED;
            PG8_LDB(B0, 1, 0); PG8_LDB(B1, 1, 1); PG8_SCHED; PG8_LDA(At, 1, 0); PG8_STAGE(PG8_SA(0, 1), a2 + hsA, voffA);
            PG8_WAIT_V(8); PG8_WAIT_L(0); PG8_BAR; PG8_MMA(0, 0, At, B0); PG8_MMA(0, 1, At, B1); PG8_BAR; PG8_SCHED;
            PG8_LDA(At, 1, 1); PG8_STAGE(PG8_SB(1, 0), b3, voffB); PG8_STAGE(PG8_SB(1, 1), b3 + hsB, voffB); PG8_STAGE(PG8_SA(1, 0), a3, voffA);
            PG8_WAIT_V(8); PG8_WAIT_L(0); PG8_BAR; PG8_MMA(1, 0, At, B0); PG8_MMA(1, 1, At, B1); PG8_BAR; PG8_SCHED;
        }
        if (wr == 0) PG8_BAR;
        E(acc, cur, wr, wc, fr, fq);
        if (!has_next) break;
#pragma unroll
        for (int a = 0; a < 2; ++a)
#pragma unroll
            for (int b = 0; b < 2; ++b)
#pragma unroll
                for (int m = 0; m < 4; ++m)
#pragma unroll
                    for (int n = 0; n < 2; ++n) acc[a][b][m][n] = (f32x4){0.f, 0.f, 0.f, 0.f};
        cur = nxt; cA = nA; cB = nB; ++ui;
        if (wr == 1) PG8_BAR;
    }
    PG8_WAIT_V(0);
    PG8_BAR;
#undef PG8_SA
#undef PG8_SB
#undef PG8_STAGE
#undef PG8_LDA
#undef PG8_LDB
#undef PG8_MMA
#undef PG8_WAIT_V
#undef PG8_WAIT_L
#undef PG8_BAR
#undef PG8_SCHED
}
}

typedef const f32x4 (&AccRef)[2][2][4][2];
constexpr int TAB_OFF = 131072, TABB_OFF = TAB_OFF + 4096;
__device__ __forceinline__ int tab_idx(int pm, int r) { return (((pm >> 3) & 3) << 8) | (r & 255); }
__device__ __forceinline__ float tabA(LAS unsigned char* lds, int pm, int r) { return *(const LAS float*)(lds + TAB_OFF + 4 * tab_idx(pm, r)); }
__device__ __forceinline__ float tabB(LAS unsigned char* lds, int pm, int r) { return *(const LAS float*)(lds + TABB_OFF + 4 * tab_idx(pm, r)); }
__device__ __forceinline__ int tab_row(int bx, int idx) { return (8 * (4 * (bx & 7) + (idx >> 8)) + ((bx >> 3) & 7)) * 256 + (idx & 255); }

__device__ __forceinline__ f32x4 silu_mul(f32x4 g, f32x4 u, float rstd) {
    const float c2 = -LOG2E * rstd, r2 = rstd * rstd; f32x4 o;
#pragma unroll
    for (int h = 0; h < 2; ++h) {
        const f32x2 gg = (f32x2){g[2 * h], g[2 * h + 1]}, uu = (f32x2){u[2 * h], u[2 * h + 1]};
        const f32x2 ar = gg * c2; f32x2 e; e.x = __builtin_amdgcn_exp2f(ar.x); e.y = __builtin_amdgcn_exp2f(ar.y);
        const f32x2 d = e + 1.0f; f32x2 r; r.x = __builtin_amdgcn_rcpf(d.x); r.y = __builtin_amdgcn_rcpf(d.y);
        const f32x2 p = ((gg * uu) * r2) * r;
        o[2 * h] = p.x; o[2 * h + 1] = p.y;
    }
    return o;
}
__device__ __forceinline__ u32x4 pack8(f32x4 a, f32x4 b) { u32x4 w; w.x = cvt_pk_bf16(a[0], a[1]); w.y = cvt_pk_bf16(a[2], a[3]); w.z = cvt_pk_bf16(b[0], b[1]); w.w = cvt_pk_bf16(b[2], b[3]); return w; }
__device__ __forceinline__ f32x4 bf_lo4(u32x4 w) { return (f32x4){__builtin_bit_cast(float, w.x << 16), __builtin_bit_cast(float, w.x & 0xffff0000u), __builtin_bit_cast(float, w.y << 16), __builtin_bit_cast(float, w.y & 0xffff0000u)}; }
__device__ __forceinline__ f32x4 bf_hi4(u32x4 w) { return (f32x4){__builtin_bit_cast(float, w.z << 16), __builtin_bit_cast(float, w.z & 0xffff0000u), __builtin_bit_cast(float, w.w << 16), __builtin_bit_cast(float, w.w & 0xffff0000u)}; }
__device__ __forceinline__ void rot8(f32x4& v0, f32x4& v1, f32x4 t0, f32x4 t1) {
    const f32x4 a = v0, b = v1;
    v0[0] = a[0] * t0[0] - a[1] * t0[1]; v0[1] = a[1] * t0[0] + a[0] * t0[1]; v0[2] = a[2] * t0[2] - a[3] * t0[3]; v0[3] = a[3] * t0[2] + a[2] * t0[3];
    v1[0] = b[0] * t1[0] - b[1] * t1[1]; v1[1] = b[1] * t1[0] + b[0] * t1[1]; v1[2] = b[2] * t1[2] - b[3] * t1[3]; v1[3] = b[3] * t1[2] + b[2] * t1[3];
}

struct EpiSwiGLU {
    static constexpr bool PERM = true;
    bf16_t* O; LAS unsigned char* lds;
    __device__ __forceinline__ void operator()(AccRef acc, const pg8::Unit& u, int wr, int wc, int fr, int fq) const {
        const int row0 = u.pm * 256 + wr * 64 + fr, col0 = u.pn * 128 + wc * 32 + 8 * fq;
#pragma unroll
        for (int ai = 0; ai < 2; ++ai)
#pragma unroll
            for (int m = 0; m < 4; ++m) {
                const int r = row0 + ai * 128 + m * 16; const float rstd = tabA(lds, u.pm, r);
                const f32x4 v0 = silu_mul(acc[ai][0][m][0], acc[ai][1][m][0], rstd), v1 = silu_mul(acc[ai][0][m][1], acc[ai][1][m][1], rstd);
                __builtin_nontemporal_store(pack8(v0, v1), (u32x4*)(O + (size_t)r * DFF + col0));
            }
    }
};

template <bool USE_TAB>
struct EpiResid {
    static constexpr bool PERM = true;
    bf16_t* HBo; float* stats; float alpha; LAS unsigned char* lds;
    __device__ __forceinline__ void operator()(AccRef acc, const pg8::Unit& u, int wr, int wc, int fr, int fq) const {
        const int row0 = u.pm * 256 + wr * 64 + fr, c0 = u.pn * 256 + wc * 32 + 8 * fq;
        u32x4 bs[8][2];
#define RES_LOAD(it_) do { const u32x4* p = (const u32x4*)(HBo + (size_t)(row0 + ((it_) >> 2) * 128 + ((it_) & 3) * 16) * DM + c0); bs[it_][0] = p[0]; bs[it_][1] = p[16]; } while (0)
        RES_LOAD(0); RES_LOAD(1); RES_LOAD(2); RES_LOAD(3);
#pragma unroll
        for (int it = 0; it < 8; ++it) {
            if (it + 4 < 8) { RES_LOAD((it + 4) & 7); }
            const int ai = it >> 2, m = it & 3, r = row0 + ai * 128 + m * 16;
            const float sc = USE_TAB ? tabB(lds, u.pm, r) : alpha;
            float ss = 0.f;
#pragma unroll
            for (int bj = 0; bj < 2; ++bj) {
                const f32x4 v0 = bf_lo4(bs[it][bj]) + acc[ai][bj][m][0] * sc, v1 = bf_hi4(bs[it][bj]) + acc[ai][bj][m][1] * sc;
                ss += sq4(v0) + sq4(v1);
                *(u32x4*)(HBo + (size_t)r * DM + c0 + bj * 128) = pack8(v0, v1);
            }
            ss = quad_sum(ss);
            if (fq == 0) stats[(size_t)r * 16 + u.pn * 4 + wc] = ss;
        }
#undef RES_LOAD
    }
};
struct EpiFinal {
    static constexpr bool PERM = true;
    const bf16_t* HBi; float* stats; float* out; const float* gfin; unsigned* pcnt; float alpha;
    __device__ __forceinline__ void operator()(AccRef acc, const pg8::Unit& u, int wr, int wc, int fr, int fq) const {
        const int row0 = u.pm * 256 + wr * 64 + fr, c0 = u.pn * 256 + wc * 32 + 8 * fq;
        f32x4 v[8][2][2];
        u32x4 bs[8][2];
#define FIN_LOAD(it_) do { const u32x4* p = (const u32x4*)(HBi + (size_t)(row0 + ((it_) >> 2) * 128 + ((it_) & 3) * 16) * DM + c0); bs[it_][0] = p[0]; bs[it_][1] = p[16]; } while (0)
        FIN_LOAD(0); FIN_LOAD(1); FIN_LOAD(2); FIN_LOAD(3);
#pragma unroll
        for (int it = 0; it < 8; ++it) {
            if (it + 4 < 8) { FIN_LOAD((it + 4) & 7); }
            const int ai = it >> 2, m = it & 3, r = row0 + ai * 128 + m * 16;
            float ss = 0.f;
#pragma unroll
            for (int bj = 0; bj < 2; ++bj) {
                v[it][bj][0] = bf_lo4(bs[it][bj]) + acc[ai][bj][m][0] * alpha; v[it][bj][1] = bf_hi4(bs[it][bj]) + acc[ai][bj][m][1] * alpha;
                ss += sq4(v[it][bj][0]) + sq4(v[it][bj][1]);
            }
            ss = quad_sum(ss);
            if (fq == 0) __hip_atomic_store(stats + (size_t)r * 16 + u.pn * 4 + wc, ss, __ATOMIC_RELAXED, __HIP_MEMORY_SCOPE_AGENT);
        }
#undef FIN_LOAD
        asm volatile("s_waitcnt vmcnt(0)" ::: "memory");
        __builtin_amdgcn_s_barrier();
        if (threadIdx.x == 0) {
            unsigned* c = pcnt + 16 * u.pm;
            __hip_atomic_fetch_add(c, 1u, __ATOMIC_RELAXED, __HIP_MEMORY_SCOPE_AGENT);
            unsigned spins = 0;
            while (__hip_atomic_load(c, __ATOMIC_RELAXED, __HIP_MEMORY_SCOPE_AGENT) < 4u) { __builtin_amdgcn_s_sleep(1); if (++spins > (1u << 22)) break; }
            __builtin_amdgcn_fence(__ATOMIC_ACQUIRE, "agent");
            asm volatile("s_waitcnt vmcnt(0)" ::: "memory");
        }
        __builtin_amdgcn_s_barrier();
        asm volatile("" ::: "memory");
        f32x4 gf[2][2];
#pragma unroll
        for (int bj = 0; bj < 2; ++bj) { gf[bj][0] = *(const f32x4*)(gfin + c0 + bj * 128); gf[bj][1] = *(const f32x4*)(gfin + c0 + bj * 128 + 4); }
#pragma unroll
        for (int it = 0; it < 8; ++it) {
            const int r = row0 + (it >> 2) * 128 + (it & 3) * 16;
            const float* sp = stats + (size_t)r * 16 + 4 * fq;
            f32x4 st; st.x = __hip_atomic_load(sp, __ATOMIC_RELAXED, __HIP_MEMORY_SCOPE_AGENT); st.y = __hip_atomic_load(sp + 1, __ATOMIC_RELAXED, __HIP_MEMORY_SCOPE_AGENT);
            st.z = __hip_atomic_load(sp + 2, __ATOMIC_RELAXED, __HIP_MEMORY_SCOPE_AGENT); st.w = __hip_atomic_load(sp + 3, __ATOMIC_RELAXED, __HIP_MEMORY_SCOPE_AGENT);
            const float rstd = 1.0f / sqrtf(quad_sum(sum4(st)) * (1.0f / DM) + EPS);
#pragma unroll
            for (int bj = 0; bj < 2; ++bj) { float* op = out + (size_t)r * DM + c0 + bj * 128;
                __builtin_nontemporal_store(v[it][bj][0] * rstd * gf[bj][0], (f32x4*)op); __builtin_nontemporal_store(v[it][bj][1] * rstd * gf[bj][1], (f32x4*)(op + 4)); }
        }
    }
};
struct MidWo {
    static constexpr bool ON = true;
    LAS unsigned char* lds;
    __device__ __forceinline__ void apply(f32x4 (&acc)[2][2][4][2], const pg8::Unit& u, int wr, int fr, int fq) const {
        const int row0 = u.pm * 256 + wr * 64 + fr;
#pragma unroll
        for (int ai = 0; ai < 2; ++ai)
#pragma unroll
            for (int m = 0; m < 4; ++m) {
                const float ratio = tabA(lds, u.pm, row0 + ai * 128 + m * 16);
#pragma unroll
                for (int bj = 0; bj < 2; ++bj)
#pragma unroll
                    for (int n = 0; n < 2; ++n) acc[ai][bj][m][n] = acc[ai][bj][m][n] * ratio;
            }
    }
};
struct EpiProj {
    static constexpr bool PERM = true;
    bf16_t* P; float* pq; float* pkv; const f32x2* rope; LAS unsigned char* lds;
    __device__ __forceinline__ void operator()(AccRef acc, const pg8::Unit& u, int wr, int wc, int fr, int fq) const {
        const int row0 = u.pm * 256 + wr * 64 + fr, col0 = u.pn * 256 + wc * 32 + 8 * fq;
        const bool is0 = (u.pn == 0), is1 = (u.pn == 1), dorope = is1 && (wc == 0);
#pragma unroll
        for (int ai = 0; ai < 2; ++ai)
#pragma unroll
            for (int m = 0; m < 4; ++m) {
                const int r = row0 + ai * 128 + m * 16; const float rstd = tabA(lds, u.pm, r);
                f32x4 v00 = acc[ai][0][m][0] * rstd, v01 = acc[ai][0][m][1] * rstd, v10 = acc[ai][1][m][0] * rstd, v11 = acc[ai][1][m][1] * rstd;
                if (is0 | is1) { float ss = sq4(v00) + sq4(v01); if (is0) ss += sq4(v10) + sq4(v11); ss = quad_sum(ss); if (fq == 0) (is0 ? pq : pkv)[(size_t)r * 4 + wc] = ss; }
                {
                    f32x4 t0 = (f32x4){1.f, 0.f, 1.f, 0.f}, t1 = t0;
                    if (dorope) { const f32x4* tp = (const f32x4*)(rope + (size_t)(r & (SEQ - 1)) * 16 + 4 * fq); t0 = tp[0]; t1 = tp[1]; }
                    rot8(v10, v11, t0, t1);
                }
                *(u32x4*)(P + (size_t)r * NPROJ + col0) = pack8(v00, v01);
                *(u32x4*)(P + (size_t)r * NPROJ + col0 + 128) = pack8(v10, v11);
            }
    }
};
struct EpiQ {
    static constexpr bool PERM = true;
    bf16_t* Q; const f32x2* rope; LAS unsigned char* lds;
    __device__ __forceinline__ void operator()(AccRef acc, const pg8::Unit& u, int wr, int wc, int fr, int fq) const {
        const int row0 = u.pm * 256 + wr * 64 + fr, col0 = u.pn * 256 + wc * 32 + 8 * fq;
#pragma unroll
        for (int ai = 0; ai < 2; ++ai)
#pragma unroll
            for (int m = 0; m < 4; ++m) {
                const int r = row0 + ai * 128 + m * 16; const float rstd = tabA(lds, u.pm, r);
#pragma unroll
                for (int bj = 0; bj < 2; ++bj) { const int c0 = col0 + bj * 128, w = c0 % 96;
                    f32x4 v0 = acc[ai][bj][m][0] * rstd, v1 = acc[ai][bj][m][1] * rstd;
                    f32x4 t0 = (f32x4){1.f, 0.f, 1.f, 0.f}, t1 = t0;
                    if (w >= 64) { const f32x4* tp = (const f32x4*)(rope + (size_t)(r & (SEQ - 1)) * 16 + ((w - 64) >> 1)); t0 = tp[0]; t1 = tp[1]; }
                    rot8(v0, v1, t0, t1);
                    *(u32x4*)(Q + (size_t)r * NQ + c0) = pack8(v0, v1); }
            }
    }
};
struct EpiKV {
    static constexpr bool PERM = true;
    bf16_t* KV; LAS unsigned char* lds;
    __device__ __forceinline__ void operator()(AccRef acc, const pg8::Unit& u, int wr, int wc, int fr, int fq) const {
        const int row0 = u.pm * 256 + wr * 64 + fr, col0 = u.pn * 256 + wc * 32 + 8 * fq;
#pragma unroll
        for (int ai = 0; ai < 2; ++ai)
#pragma unroll
            for (int m = 0; m < 4; ++m) {
                const int r = row0 + ai * 128 + m * 16; const float rstd = tabB(lds, u.pm, r);
#pragma unroll
                for (int bj = 0; bj < 2; ++bj)
                    *(u32x4*)(KV + (size_t)r * NKV + col0 + bj * 128) = pack8(acc[ai][bj][m][0] * rstd, acc[ai][bj][m][1] * rstd);
            }
    }
};

struct AttnT { const bf16_t* qmla; const bf16_t* kv; const bf16_t* proj; bf16_t* o; float* po; const float* bias; const float* sinks; };

template <bool SWA>
__device__ __forceinline__ void attn_unit(LAS unsigned char* lds, int b, int h, int qb, const AttnT& T, bool have) {
    constexpr int DQK = SWA ? 64 : 96, NS = DQK / 32, KP = DQK * 2 + 16, VP = 160;
    constexpr int KBUF = 16384, VOFF = 32768, VBUF = 16384, BIASOFF = 65536;
    const int tid = threadIdx.x, lane = tid & 63, wid = __builtin_amdgcn_readfirstlane(tid >> 6), l15 = lane & 15, g = lane >> 4;
    const int Q0 = SWA ? qb * 64 : qb * 256, q0w = SWA ? Q0 + 32 * (wid & 1) : Q0 + 32 * wid, hw = SWA ? 4 * h + (wid >> 1) : h;
    const size_t tok0 = (size_t)b * SEQ;
    bf16x8 Qf[2][NS];
#pragma unroll
    for (int sb = 0; sb < 2; ++sb)
#pragma unroll
        for (int s = 0; s < NS; ++s) {
            const size_t row = tok0 + q0w + 16 * sb + l15;
            const bf16_t* p = SWA ? T.proj + row * NPROJ + PC_QS + 64 * hw + 32 * s + 8 * g : T.qmla + row * NQ + 96 * h + 32 * s + 8 * g;
            Qf[sb][s] = *(const bf16x8*)p;
        }
    f32x4 negm[2], lacc[2], oT[2][4];
    const bf16x8 ones = (bf16x8){0x3F80, 0x3F80, 0x3F80, 0x3F80, 0x3F80, 0x3F80, 0x3F80, 0x3F80};
#pragma unroll
    for (int sb = 0; sb < 2; ++sb) {
        if (SWA) { const float ms = -T.sinks[hw] * LOG2E; negm[sb] = (f32x4){ms, ms, ms, ms}; lacc[sb] = (f32x4){1.f, 1.f, 1.f, 1.f}; } else { negm[sb] = (f32x4){0.f, 0.f, 0.f, 0.f}; lacc[sb] = negm[sb]; }
#pragma unroll
        for (int c = 0; c < 4; ++c) oT[sb][c] = (f32x4){0.f, 0.f, 0.f, 0.f};
    }
    const int kbase = SWA ? Q0 - 128 : 0, j0 = SWA ? (Q0 < 128 ? (128 - Q0) / 64 : 0) : 0, NT = SWA ? 3 : 4 * (qb + 1);
    const int skey = tid >> 3, sch = tid & 7;
    const bf16_t* ksrc; const bf16_t* vsrc; const bf16_t* pesrc = nullptr; size_t kpitch;
    if (SWA) { const int kvh = h; ksrc = T.proj + (tok0 + skey) * NPROJ + PC_KS + 64 * kvh + 8 * sch; vsrc = ksrc + (PC_VS - PC_KS); kpitch = NPROJ; }
    else { ksrc = T.kv + (tok0 + skey) * NKV + 128 * h + 8 * sch; vsrc = ksrc + 64; kpitch = NKV; pesrc = T.proj + (tok0 + (tid >> 2)) * NPROJ + PC_KPE + 8 * (tid & 3); }
    const int kdst = skey * KP + 16 * sch, vdst = VOFF + skey * VP + 16 * sch, pedst = (tid >> 2) * KP + 128 + 16 * (tid & 3);
    if (SWA && !have) { for (int e = tid; e < 4 * 320; e += 512) { const int hl = e / 320, x = e % 320, d = 223 - x;
            *(LAS float*)(lds + BIASOFF + 4 * e) = ((unsigned)d < 128u) ? T.bias[(4 * h + hl) * 128 + d] : -1e30f; } }
    u32x4 rk, rv, rpe = (u32x4){0u, 0u, 0u, 0u};
#define AT_LOAD(j) do { const size_t k0_ = (size_t)(kbase + 64 * (j)); rk = *(const u32x4*)(ksrc + k0_ * kpitch); rv = *(const u32x4*)(vsrc + k0_ * kpitch); \
        if (!SWA) { if (tid < 256) rpe = *(const u32x4*)(pesrc + k0_ * NPROJ); } } while (0)
#define AT_STORE(bi) do { *(LAS u32x4*)(lds + (bi) * KBUF + kdst) = rk; *(LAS u32x4*)(lds + (bi) * VBUF + vdst) = rv; \
        if (!SWA) { if (tid < 256) *(LAS u32x4*)(lds + (bi) * KBUF + pedst) = rpe; } } while (0)
    AT_LOAD(j0); AT_STORE(0);
    if (j0 + 1 < NT) AT_LOAD(j0 + 1);
    __syncthreads();
    for (int j = j0; j < NT; ++j) {
        const bool more = j + 1 < NT; const int bi = (j - j0) & 1; const int k0 = kbase + 64 * j;
        if (more) AT_STORE(bi ^ 1);
        if (j + 2 < NT) AT_LOAD(j + 2);
        const bool active = SWA ? (k0 + 63 >= q0w - 127 && k0 <= q0w + 31) : (k0 <= q0w + 31);
        if (active) {
            const LAS unsigned char* Kb = lds + bi * KBUF; const LAS unsigned char* Vb = lds + VOFF + bi * VBUF;
            f32x4 sT[2][4];
#pragma unroll
            for (int kb = 0; kb < 4; ++kb) {
                const int rowk = 16 * kb + l15;
                sT[0][kb] = negm[0]; sT[1][kb] = negm[1];
#pragma unroll
                for (int s = 0; s < NS; ++s) {
                    const bf16x8 Kf = *(const LAS bf16x8*)(Kb + rowk * KP + (32 * s + 8 * g) * 2);
                    sT[0][kb] = __builtin_amdgcn_mfma_f32_16x16x32_bf16(Kf, Qf[0][s], sT[0][kb], 0, 0, 0);
                    sT[1][kb] = __builtin_amdgcn_mfma_f32_16x16x32_bf16(Kf, Qf[1][s], sT[1][kb], 0, 0, 0);
                }
            }
            const bool need_mask = SWA ? true : (k0 + 63 > q0w);
            u32x4 pw[2][2];
#pragma unroll
            for (int sb = 0; sb < 2; ++sb) {
                const int q = q0w + 16 * sb + l15;
                if (SWA) {
                    const LAS float* bt = (const LAS float*)(lds + BIASOFF) + (wid >> 1) * 320 + (223 - q + k0 + 4 * g);
#pragma unroll
                    for (int kb = 0; kb < 4; ++kb)
#pragma unroll
                        for (int i = 0; i < 4; ++i) sT[sb][kb][i] += bt[16 * kb + i];
                } else if (need_mask) {
#pragma unroll
                    for (int kb = 0; kb < 4; ++kb)
#pragma unroll
                        for (int i = 0; i < 4; ++i) { const int key = k0 + 16 * kb + 4 * g + i; if (key > q) sT[sb][kb][i] = -1e30f; }
                }
                const bool first = (!SWA) && (j == 0);
                if (first || (SWA ? (j == j0) : ((j & 15) == 0))) {
                float mx = fmaxf(fmaxf(sT[sb][0][0], sT[sb][0][1]), sT[sb][0][2]);
                mx = fmaxf(fmaxf(mx, sT[sb][0][3]), sT[sb][1][0]); mx = fmaxf(fmaxf(mx, sT[sb][1][1]), sT[sb][1][2]); mx = fmaxf(fmaxf(mx, sT[sb][1][3]), sT[sb][2][0]);
                mx = fmaxf(fmaxf(mx, sT[sb][2][1]), sT[sb][2][2]); mx = fmaxf(fmaxf(mx, sT[sb][2][3]), sT[sb][3][0]); mx = fmaxf(fmaxf(mx, sT[sb][3][1]), sT[sb][3][2]);
                mx = fmaxf(mx, sT[sb][3][3]);
                mx = quad_max(mx);
                if (first || __any(mx > 6.f)) {
                    const float delta = first ? mx : fmaxf(mx, 0.f); negm[sb] = negm[sb] - delta;
                    if (!first) { const float alpha = __builtin_amdgcn_exp2f(-delta); lacc[sb] = lacc[sb] * alpha;
#pragma unroll
                        for (int c = 0; c < 4; ++c) oT[sb][c] = oT[sb][c] * alpha; }
#pragma unroll
                    for (int kb = 0; kb < 4; ++kb) sT[sb][kb] = sT[sb][kb] - delta;
                }
                }
#pragma unroll
                for (int kb = 0; kb < 4; ++kb)
#pragma unroll
                    for (int i = 0; i < 4; ++i) sT[sb][kb][i] = __builtin_amdgcn_exp2f(sT[sb][kb][i]);
#pragma unroll
                for (int ks = 0; ks < 2; ++ks) pw[sb][ks] = pack8(sT[sb][2 * ks], sT[sb][2 * ks + 1]);
            }
#pragma unroll
            for (int ks = 0; ks < 2; ++ks) {
                const bf16x8 P0 = __builtin_bit_cast(bf16x8, pw[0][ks]), P1 = __builtin_bit_cast(bf16x8, pw[1][ks]);
                lacc[0] = __builtin_amdgcn_mfma_f32_16x16x32_bf16(ones, P0, lacc[0], 0, 0, 0); lacc[1] = __builtin_amdgcn_mfma_f32_16x16x32_bf16(ones, P1, lacc[1], 0, 0, 0);
#pragma unroll
                for (int c = 0; c < 4; ++c) {
                    const LAS unsigned char* ta = Vb + (32 * ks + 4 * g + (l15 >> 2)) * VP + (16 * c + 4 * (lane & 3)) * 2;
                    const s16x4 lo = __builtin_amdgcn_ds_read_tr16_b64_v4i16((LAS s16x4*)ta);
                    const s16x4 hi = __builtin_amdgcn_ds_read_tr16_b64_v4i16((LAS s16x4*)(ta + 16 * VP));
                    const bf16x8 Vf = (bf16x8){lo[0], lo[1], lo[2], lo[3], hi[0], hi[1], hi[2], hi[3]};
                    oT[0][c] = __builtin_amdgcn_mfma_f32_16x16x32_bf16(Vf, P0, oT[0][c], 0, 0, 0);
                    oT[1][c] = __builtin_amdgcn_mfma_f32_16x16x32_bf16(Vf, P1, oT[1][c], 0, 0, 0);
                }
            }
        }
        asm volatile("s_waitcnt lgkmcnt(0)" ::: "memory");
        __builtin_amdgcn_s_barrier();
        asm volatile("" ::: "memory");
    }
#undef AT_LOAD
#undef AT_STORE
#pragma unroll
    for (int sb = 0; sb < 2; ++sb) {
        const float inv = 1.0f / lacc[sb][0];
        const size_t row = tok0 + q0w + 16 * sb + l15; float ss = 0.f;
        u32x2 w[4];
#pragma unroll
        for (int c = 0; c < 4; ++c) { const f32x4 v = oT[sb][c] * inv; ss += sq4(v); w[c].x = cvt_pk_bf16(v[0], v[1]); w[c].y = cvt_pk_bf16(v[2], v[3]); }
#pragma unroll
        for (int c = 0; c < 4; c += 2) {
            auto sx = __builtin_amdgcn_permlane16_swap(w[c].x, w[c + 1].x, false, false); auto sy = __builtin_amdgcn_permlane16_swap(w[c].y, w[c + 1].y, false, false);
            const u32x4 o = (u32x4){sx[0], sy[0], sx[1], sy[1]};
            const int col = (g & 1) ? 16 * (c + 1) + 4 * (g - 1) : 16 * c + 4 * g;
            *(u32x4*)(T.o + row * DM + (SWA ? 512 : 0) + 64 * hw + col) = o;
        }
        ss = quad_sum(ss);
        if (g == 0) T.po[row * 16 + (SWA ? 8 : 0) + hw] = ss;
    }
}


#if defined(DBG_NAIVE_SWA)
__device__ __forceinline__ float bf2f(bf16_t v) { return __builtin_bit_cast(float, (unsigned)v << 16); }
__device__ __forceinline__ void naive_swa(const AttnT& T, int gt, int NGT) {
    for (int idx = gt; idx < MTOK * 8; idx += NGT) {
        const int t = idx >> 3, hq = idx & 7, s = t & (SEQ - 1), kvh = hq >> 2;
        float q[64], o[64];
#pragma unroll
        for (int d = 0; d < 64; ++d) { q[d] = bf2f(T.proj[(size_t)t * NPROJ + PC_QS + 64 * hq + d]); o[d] = 0.f; }
        float m = T.sinks[hq] * LOG2E, l = 1.f;
        const int klo = s - 127 < 0 ? 0 : s - 127;
        for (int k = klo; k <= s; ++k) {
            const size_t kr = (size_t)(t - s + k) * NPROJ;
            float sc = 0.f;
#pragma unroll
            for (int d = 0; d < 64; ++d) sc += q[d] * bf2f(T.proj[kr + PC_KS + 64 * kvh + d]);
            sc += T.bias[hq * 128 + (s - k)];
            const float mn = fmaxf(m, sc), al = exp2f(m - mn), p = exp2f(sc - mn); m = mn; l = l * al + p;
#pragma unroll
            for (int d = 0; d < 64; ++d) o[d] = o[d] * al + p * bf2f(T.proj[kr + PC_VS + 64 * kvh + d]);
        }
        float ss = 0.f; const float inv = 1.f / l;
#pragma unroll
        for (int d = 0; d < 64; d += 2) { const float a = o[d] * inv, b = o[d + 1] * inv; ss += a * a + b * b; *(unsigned*)(T.o + (size_t)t * DM + 512 + 64 * hq + d) = cvt_pk_bf16(a, b); }
        T.po[(size_t)t * 16 + 8 + hq] = ss;
    }
}
#endif


#if defined(DBG_NAIVE_PROJ)
__device__ __forceinline__ float bf2f_(bf16_t v) { return __builtin_bit_cast(float, (unsigned)v << 16); }
__device__ __forceinline__ void naive_proj_swa(const bf16_t* HB, const float* stats, const float* gmix, const float* win, bf16_t* proj, int gt, int NGT) {
    for (int idx = gt; idx < MTOK * 768; idx += NGT) {
        const int t = idx / 768, j = idx % 768, n = 416 + j;
        float ssum = 0.f;
        for (int i = 0; i < 16; ++i) ssum += stats[(size_t)t * 16 + i];
        const float rstd = 1.0f / sqrtf(ssum * (1.0f / DM) + EPS);
        float acc = 0.f;
        for (int k = 0; k < DM; ++k) acc += bf2f_(HB[(size_t)t * DM + k]) * (gmix[k] * win[(size_t)k * 1184 + n]);
        const float val = acc * rstd * (j < 512 ? 0.125f * LOG2E : 1.0f);
        const int dest = j < 512 ? PC_QS + j : (j < 640 ? PC_KS + (j - 512) : PC_VS + (j - 640));
        proj[(size_t)t * NPROJ + dest] = (bf16_t)(cvt_pk_bf16(val, 0.f) & 0xffffu);
    }
}
#endif

#define RLX_AGENT __ATOMIC_RELAXED, __HIP_MEMORY_SCOPE_AGENT
#define XB_TMO      128
#define XB_XCNT(j)  (256  + 64 * (j))
#define XB_XSUB(j)  (1280 + 64 * (j))
#define XB_XGEN(j)  (2304 + 64 * (j))
#define XB_TOP      3328
#define XB_TOPGEN   3392
#define XCD_BAR_WORDS 3456
#define XB_SPIN_CAP (1u << 18)

__device__ __forceinline__ unsigned xb_ld(unsigned* p)              { return __hip_atomic_load(p, __ATOMIC_RELAXED, __HIP_MEMORY_SCOPE_AGENT); }
__device__ __forceinline__ unsigned xb_add(unsigned* p, unsigned v) { return __hip_atomic_fetch_add(p, v, __ATOMIC_RELAXED, __HIP_MEMORY_SCOPE_AGENT); }
__device__ __forceinline__ unsigned xb_xcc_id() { return (unsigned)__builtin_amdgcn_s_getreg((3 << 11) | 20) & 0xFu; }
#define XB_SPIN(cond, bar) do { unsigned _sp = 0; while (cond) { __builtin_amdgcn_s_sleep(1); \
    if ((++_sp & 255u) == 0u) { if (xb_ld(&(bar)[XB_TMO])) break; if (_sp > XB_SPIN_CAP) { atomicAdd(&(bar)[XB_TMO], 1u); break; } } } } while (0)

struct XcdBarrier {
    unsigned* bar; unsigned x;
    volatile LAS unsigned* st;
};

__device__ __forceinline__ XcdBarrier xcd_barrier_post(unsigned* bar, volatile LAS unsigned* st) {
    XcdBarrier b; b.bar = bar; b.x = xb_xcc_id(); b.st = st;
    if (threadIdx.x == 0) (void)xb_add(&bar[XB_XCNT(b.x)], 1u);
    return b;
}
__device__ __forceinline__ void xcd_barrier_complete(unsigned* bar, unsigned x, unsigned& nloc, unsigned& nx) {
    const unsigned G = gridDim.x * gridDim.y * gridDim.z;
    unsigned sum, cnt, mine, sp = 0u;
    for (;;) {
        sum = 0u; cnt = 0u; mine = 0u;
#pragma unroll
        for (unsigned j = 0; j < 16; ++j) { const unsigned c = xb_ld(&bar[XB_XCNT(j)]); sum += c; cnt += (c > 0u) ? 1u : 0u; mine = (j == x) ? c : mine; }
        if (sum == G) break;
        __builtin_amdgcn_s_sleep(1);
        if ((++sp & 255u) == 0u) { if (xb_ld(&bar[XB_TMO])) break; if (sp > XB_SPIN_CAP) { atomicAdd(&bar[XB_TMO], 1u); break; } }
    }
    nloc = mine > 0u ? mine : 1u; nx = cnt > 0u ? cnt : 1u;
}

__device__ __forceinline__ void xcd_barrier(const XcdBarrier& b) {
    asm volatile("s_waitcnt vmcnt(0)" ::: "memory");
    __syncthreads();
    if (threadIdx.x == 0) {
        unsigned* bar = b.bar;
        __builtin_amdgcn_s_waitcnt(0);
        unsigned nloc = b.st[0], nx = b.st[1];
        if (nloc == 0u) { xcd_barrier_complete(bar, b.x, nloc, nx); b.st[0] = nloc; b.st[1] = nx; }
        const unsigned old = xb_add(&bar[XB_XSUB(b.x)], 1u);
        const unsigned gen = old / nloc;
        if (old + 1u == (gen + 1u) * nloc) {
            __builtin_amdgcn_fence(__ATOMIC_RELEASE, "agent");
            asm volatile("s_waitcnt vmcnt(0)" ::: "memory");
            const unsigned og = xb_add(&bar[XB_TOP], 1u);
            const unsigned tg = og / nx;
            if (og + 1u == (tg + 1u) * nx) xb_add(&bar[XB_TOPGEN], 1u);
            else XB_SPIN(xb_ld(&bar[XB_TOPGEN]) == tg, bar);
            __builtin_amdgcn_fence(__ATOMIC_ACQUIRE, "agent");
            xb_add(&bar[XB_XGEN(b.x)], 1u);
            asm volatile("s_waitcnt vmcnt(0)" ::: "memory");
        } else {
            XB_SPIN(xb_ld(&bar[XB_XGEN(b.x)]) == gen, bar);
            __builtin_amdgcn_fence(__ATOMIC_ACQUIRE, "agent");
            asm volatile("s_waitcnt vmcnt(0)" ::: "memory");
        }
    }
    __syncthreads();
}

__device__ __forceinline__ unsigned f2bf(float f) { unsigned u = __builtin_bit_cast(unsigned, f); return (u + 0x7fffu + ((u >> 16) & 1u)) >> 16; }
__device__ __forceinline__ unsigned pk2(float lo, float hi) { return cvt_pk_bf16(lo, hi); }
enum MatId { ID_GATE = 0, ID_UP, ID_PLAIN, ID_IN, ID_QB };
__device__ __forceinline__ int rope_il(int i) { return i < 16 ? 2 * i : 2 * (i - 16) + 1; }
__device__ __forceinline__ void map_dest(int id, int n, int& row, float& sc) {
    sc = 1.f;
    if (id == ID_GATE) row = 256 * (n >> 7) + (n & 127);
    else if (id == ID_UP) row = 256 * (n >> 7) + 128 + (n & 127);
    else if (id == ID_IN) {
        if (n < 384) row = n;
        else if (n < 416) row = PC_KPE + rope_il(n - 384);
        else if (n < 928) { row = n - 416 + PC_QS; sc = 0.125f * LOG2E; }
        else if (n < 1056) row = n - 928 + PC_KS;
        else row = n - 1056 + PC_VS;
    } else if (id == ID_QB) { const int hh = n / 96, w = n % 96; row = (w < 64) ? n : 96 * hh + 64 + rope_il(w - 64); }
    else row = n;
}
struct P0Item { const float* W; int K, N; bf16_t* WT; int id; const float* ks; const float* ks2; int ksplit; int item; };
__device__ __forceinline__ void p0_item_load(const P0Item& d, float (&r)[32], int lane) {
    const int nblk = d.N / 32, kb = d.item / nblk, nb = d.item % nblk, k0 = 64 * kb, n0 = 32 * nb;
#pragma unroll
    for (int i = 0; i < 32; ++i) { const int kg = k0 + 2 * i + (lane >> 5); r[i] = d.W[(size_t)kg * d.N + n0 + (lane & 31)]; }
}
__device__ __forceinline__ void p0_item_finish(const P0Item& d, const float (&r)[32], LAS float* scr, int lane) {
    const int nblk = d.N / 32, kb = d.item / nblk, nb = d.item % nblk, k0 = 64 * kb, n0 = 32 * nb;
#pragma unroll
    for (int i = 0; i < 32; ++i) { const int kk = 2 * i + (lane >> 5), kg = k0 + kk; float v = r[i];
        if (d.ks) v *= (kg < d.ksplit) ? d.ks[kg] : d.ks2[kg - d.ksplit];
        scr[kk * 33 + (lane & 31)] = v; }
    asm volatile("s_waitcnt lgkmcnt(0)" ::: "memory");
    const int c = lane & 7;
#pragma unroll
    for (int j = 0; j < 4; ++j) { const int n = (lane >> 3) + 8 * j; const LAS float* sp = scr + (8 * c) * 33 + n; int drow; float sc; map_dest(d.id, n0 + n, drow, sc);
        u32x4 o; o.x = pk2(sp[0 * 33] * sc, sp[1 * 33] * sc); o.y = pk2(sp[2 * 33] * sc, sp[3 * 33] * sc); o.z = pk2(sp[4 * 33] * sc, sp[5 * 33] * sc); o.w = pk2(sp[6 * 33] * sc, sp[7 * 33] * sc);
        *(u32x4*)(d.WT + (size_t)drow * d.K + k0 + 8 * c) = o; }
    asm volatile("s_waitcnt lgkmcnt(0)" ::: "memory");
}
__device__ __forceinline__ void sincos_acc(float angf, float& c, float& s) {
    const double a = (double)angf; const double kq = rint(a * 0.63661977236758134); const double r = a - kq * 1.5707963267948966; const int q = ((int)kq) & 3; const double r2 = r * r;
    const double sp = r * (1.0 + r2 * (-1.0 / 6 + r2 * (1.0 / 120 + r2 * (-1.0 / 5040 + r2 * (1.0 / 362880 + r2 * (-1.0 / 39916800 + r2 * (1.0 / 6227020800.0)))))));
    const double cp = 1.0 + r2 * (-0.5 + r2 * (1.0 / 24 + r2 * (-1.0 / 720 + r2 * (1.0 / 40320 + r2 * (-1.0 / 3628800 + r2 * (1.0 / 479001600.0))))));
    const double sv = (q == 0) ? sp : (q == 1) ? cp : (q == 2) ? -sp : -cp, cv = (q == 0) ? cp : (q == 1) ? -sp : (q == 2) ? -cp : sp;
    c = (float)cv; s = (float)sv;
}

struct Args { const float* in[21]; float* out; unsigned char* ws; int ph_lo, ph_hi; };
constexpr int NPHASE = 9;

__global__ void __launch_bounds__(512, 2) mk_fwd(Args a) {
    extern __shared__ __attribute__((aligned(16))) unsigned char lds_raw[];
    LAS unsigned char* lds = (LAS unsigned char*)lds_raw;
    cg::grid_group grid = cg::this_grid();
    const int tid = threadIdx.x, lane = tid & 63, wave = __builtin_amdgcn_readfirstlane(tid >> 6);
    const int G = gridDim.x, bx = blockIdx.x;
    unsigned char* ws = a.ws;
    const float* x = a.in[0];
    f32x2* rope = (f32x2*)(ws + WS_ROPE); float* biasT = (float*)(ws + WS_BIAS);
    float* stats = (float*)(ws + WS_STATS); float* pq = (float*)(ws + WS_PQ); float* pkv = (float*)(ws + WS_PKV); float* po = (float*)(ws + WS_PO);
    bf16_t *W1gu = (bf16_t*)(ws + WS_W1GU), *W1d = (bf16_t*)(ws + WS_W1D), *W2gu = (bf16_t*)(ws + WS_W2GU), *W2d = (bf16_t*)(ws + WS_W2D);
    bf16_t *Win = (bf16_t*)(ws + WS_WIN), *Wqb = (bf16_t*)(ws + WS_WQB), *Wkvb = (bf16_t*)(ws + WS_WKVB), *Wo = (bf16_t*)(ws + WS_WO);
    bf16_t *hid = (bf16_t*)(ws + WS_HID), *proj = (bf16_t*)(ws + WS_PROJ), *qmla = (bf16_t*)(ws + WS_QMLA), *kvb = (bf16_t*)(ws + WS_KV), *ob = (bf16_t*)(ws + WS_O), *HB = (bf16_t*)(ws + WS_HB);
    const int lo = a.ph_lo, hi = a.ph_hi;
    volatile LAS unsigned* bst = (volatile LAS unsigned*)(lds + 139264);
    if (tid < 2) bst[tid] = 0u;
    __syncthreads();
    XcdBarrier xbar = xcd_barrier_post((unsigned*)(ws + WS_BAR), bst);
#ifndef PH_MASK
#define PH_MASK 0x3ff
#endif
#define IN(k) (((PH_MASK >> (k)) & 1) && lo <= (k) && (k) < hi)
#define SEAM(k) do { if (IN(k) && IN((k) + 1)) { if ((k) == 0) grid.sync(); else xcd_barrier(xbar); } } while (0)

    if (IN(0)) {
        LAS float* scr = (LAS float*)(lds + wave * 16384);
        const int gw = bx * 8 + wave, NGW = G * 8;
        constexpr int I_GU = (DM / 64) * (DFF / 32), I_D = (DFF / 64) * (DM / 32), I_IN = (DM / 64) * (1184 / 32), I_QB = (256 / 64) * (NQ / 32), I_KVB = (128 / 64) * (NKV / 32), I_O = (DM / 64) * (DM / 32);
        constexpr int NITEMS = 4 * I_GU + 2 * I_D + I_IN + I_QB + I_KVB + I_O;
#define P0_DECODE(it_, d_) do { int r = (it_); \
            if (r < I_GU) { d_ = P0Item{a.in[2], DM, DFF, W1gu, ID_GATE, a.in[1], a.in[1], DM, r}; break; } r -= I_GU; \
            if (r < I_GU) { d_ = P0Item{a.in[3], DM, DFF, W1gu, ID_UP, a.in[1], a.in[1], DM, r}; break; } r -= I_GU; \
            if (r < I_GU) { d_ = P0Item{a.in[17], DM, DFF, W2gu, ID_GATE, a.in[16], a.in[16], DM, r}; break; } r -= I_GU; \
            if (r < I_GU) { d_ = P0Item{a.in[18], DM, DFF, W2gu, ID_UP, a.in[16], a.in[16], DM, r}; break; } r -= I_GU; \
            if (r < I_D) { d_ = P0Item{a.in[4], DFF, DM, W1d, ID_PLAIN, nullptr, nullptr, 0, r}; break; } r -= I_D; \
            if (r < I_D) { d_ = P0Item{a.in[19], DFF, DM, W2d, ID_PLAIN, nullptr, nullptr, 0, r}; break; } r -= I_D; \
            if (r < I_IN) { d_ = P0Item{a.in[6], DM, 1184, Win, ID_IN, a.in[5], a.in[5], DM, r}; break; } r -= I_IN; \
            if (r < I_QB) { d_ = P0Item{a.in[8], 256, NQ, Wqb, ID_QB, a.in[7], a.in[7], 256, r}; break; } r -= I_QB; \
            if (r < I_KVB) { d_ = P0Item{a.in[10], 128, NKV, Wkvb, ID_PLAIN, a.in[9], a.in[9], 128, r}; break; } r -= I_KVB; \
            d_ = P0Item{a.in[15], DM, DM, Wo, ID_PLAIN, a.in[13], a.in[14], 512, r}; } while (0)
        if (gw < NITEMS) {
            P0Item dc, dn; float rc[32], rn[32];
            P0_DECODE(gw, dc); p0_item_load(dc, rc, lane);
            for (int it = gw; it < NITEMS; it += NGW) {
                const bool hn = it + NGW < NITEMS;
                if (hn) { P0_DECODE(it + NGW, dn); p0_item_load(dn, rn, lane); }
                p0_item_finish(dc, rc, scr, lane);
                if (hn) { dc = dn;
#pragma unroll
                    for (int i = 0; i < 32; ++i) rc[i] = rn[i]; }
            }
        }
#undef P0_DECODE
        const int gt = bx * 512 + tid, NGT = G * 512;
        for (int i = gt; i < 96 * DM / 8; i += NGT) ((u32x4*)(Win + (size_t)416 * DM))[i] = (u32x4){0u, 0u, 0u, 0u};
#if defined(DBG_NAIVE_WIN)
        __syncthreads();
        if (bx == 0) { asm volatile("s_waitcnt vmcnt(0)" ::: "memory"); }
#endif
        for (int i = gt; i < SEQ * 16; i += NGT) { const int pos = i >> 4, k = i & 15; const float inv = exp2f(-(float)(2 * k) * (1.0f / 32.0f) * 13.287712379549449f);
            float c, s; sincos_acc((float)pos * inv, c, s); rope[i] = (f32x2){c, s}; }
#if defined(DBG_NAIVE_WIN)
        for (int i = gt; i < DM * 1184; i += NGT) { const int k = i / 1184, n = i % 1184; int drow; float sc; map_dest(ID_IN, n, drow, sc);
            Win[(size_t)drow * DM + k] = (bf16_t)f2bf(a.in[6][i] * a.in[5][k] * sc); }
#endif
        for (int i = gt; i < 8 * 128; i += NGT) { const int hh = i >> 7, d = i & 127; int bk = d;
            if (d >= 16) { bk = 16 + (int)(logf((float)d / 16.0f) / 2.0794415416798357f * 16.0f); if (bk > 31) bk = 31; }
            biasT[i] = a.in[12][bk * 8 + hh] * LOG2E; }
        for (int m = gw; m < MTOK; m += NGW) {
            const f32x4* xr = (const f32x4*)(x + (size_t)m * DM) + lane; f32x4 v[4]; float s = 0.f;
#pragma unroll
            for (int j = 0; j < 4; ++j) { v[j] = xr[64 * j]; s += sq4(v[j]); }
            s = wave_sum(s);
            unsigned long long* o8 = (unsigned long long*)(HB + (size_t)m * DM) + lane;
#pragma unroll
            for (int j = 0; j < 4; ++j) o8[64 * j] = (unsigned long long)cvt_pk_bf16(v[j].x, v[j].y) | ((unsigned long long)cvt_pk_bf16(v[j].z, v[j].w) << 32);
            if (lane < 16) stats[(size_t)m * 16 + lane] = (lane == 0) ? s : 0.f;
        }
        __syncthreads();
    }
    SEAM(0);
#define TAB_FILL(expr_a, expr_b) do { for (int idx = tid; idx < 1024; idx += 512) { const int r = tab_row(bx, idx); float va, vb; { expr_a; } { expr_b; } \
        *(LAS float*)(lds + TAB_OFF + 4 * idx) = va; *(LAS float*)(lds + TABB_OFF + 4 * idx) = vb; } __syncthreads(); } while (0)
#define SUM16(p) ({ const f32x4* q_ = (const f32x4*)((p) + (size_t)r * 16); sum4(q_[0]) + sum4(q_[1]) + sum4(q_[2]) + sum4(q_[3]); })
#define FFN_UP(Wgu) do { TAB_FILL(va = rsq(SUM16(stats) * (1.0f / DM) + EPS), vb = 0.f); \
        pg8::Gemm g{HB, Wgu, MTOK, 2 * DFF, DM, DM, DM}; pg8::StaticOrder S; S.init(MTOK, 2 * DFF, G, bx); EpiSwiGLU E{hid, lds}; \
        pg8::gemm_phase(lds, g, S, E, pg8::NoMid{}); } while (0)
    if (IN(1)) FFN_UP(W1gu);
    SEAM(1);
    if (IN(2)) { pg8::Gemm g{hid, W1d, MTOK, DM, DFF, DFF, DFF}; pg8::StaticOrder S; S.init(MTOK, DM, G, bx); EpiResid<false> E{HB, stats, 0.5f, lds};
        pg8::gemm_phase(lds, g, S, E, pg8::NoMid{}); }
    SEAM(2);
    if (IN(3)) { TAB_FILL(va = rsq(SUM16(stats) * (1.0f / DM) + EPS), vb = 0.f);
        pg8::Gemm g{HB, Win, MTOK, NPROJ, DM, DM, DM}; pg8::StaticOrder S; S.init(MTOK, NPROJ, G, bx); EpiProj E{proj, pq, pkv, rope, lds};
        pg8::gemm_phase(lds, g, S, E, pg8::NoMid{}); }
    SEAM(3);
    if (IN(4)) {
        TAB_FILL(va = rsq(sum4(*(const f32x4*)(pq + (size_t)r * 4)) * (1.0f / 256.0f) + EPS) * (0.10206207261596575f * LOG2E), vb = rsq(sum4(*(const f32x4*)(pkv + (size_t)r * 4)) * (1.0f / 128.0f) + EPS));
        { pg8::Gemm g{proj, Wqb, MTOK, NQ, 256, NPROJ, 256}; pg8::StaticOrder S; S.init(MTOK, NQ, G, bx); EpiQ E{qmla, rope, lds};
          pg8::gemm_phase(lds, g, S, E, pg8::NoMid{}); }
        { pg8::Gemm g{proj + 256, Wkvb, MTOK, NKV, 128, NPROJ, 128}; pg8::StaticOrder S; S.init(MTOK, NKV, G, bx); EpiKV E{kvb, lds};
          pg8::gemm_phase(lds, g, S, E, pg8::NoMid{}); }
    }
    SEAM(4);
    if (IN(5)) {
        const AttnT T{qmla, kvb, proj, ob, po, biasT, a.in[11]};
        for (int uu = bx; uu < 256; uu += G) {
            const int b = (uu & 7) * 4 + (uu >> 6), h = (uu >> 3) & 7;
            for (int qb = 7; qb >= 0; --qb) attn_unit<false>(lds, b, h, qb, T, false);
            for (int i = 0; i < 8; ++i) attn_unit<true>(lds, b, h >> 2, (h & 3) * 8 + i, T, i != 0);
        }
    }
    SEAM(5);
    if (IN(6)) {
        TAB_FILL(const f32x4* q_ = (const f32x4*)(po + (size_t)r * 16); const float mla_ = sum4(q_[0]) + sum4(q_[1]); const float swa_ = sum4(q_[2]) + sum4(q_[3]);
                 va = rsq(mla_ * (1.0f / 512.0f) + EPS) * sqrtf(swa_ * (1.0f / 512.0f) + EPS),
                 const f32x4* q2_ = (const f32x4*)(po + (size_t)r * 16); vb = rsq((sum4(q2_[2]) + sum4(q2_[3])) * (1.0f / 512.0f) + EPS));
        pg8::Gemm g{ob, Wo, MTOK, DM, DM, DM, DM}; pg8::StaticOrder S; S.init(MTOK, DM, G, bx); EpiResid<true> E{HB, stats, 1.0f, lds}; MidWo Md{lds};
        pg8::gemm_phase(lds, g, S, E, Md); }
    SEAM(6);
    if (IN(7)) FFN_UP(W2gu);
    SEAM(7);
    if (IN(8)) { pg8::Gemm g{hid, W2d, MTOK, DM, DFF, DFF, DFF}; pg8::StaticOrder S; S.init(MTOK, DM, G, bx);
        EpiFinal E{HB, stats, a.out, a.in[20], (unsigned*)(ws + WS_BAR + 16384), 0.5f};
        pg8::gemm_phase(lds, g, S, E, pg8::NoMid{}); }
#undef IN
#undef SEAM
}

extern "C" void kernel_launch(void* const* d_in, const int* in_sizes, int n_in, void* d_out, int out_size, void* d_ws, size_t ws_size, hipStream_t stream) {
    static int grid = 0;
    if (grid == 0) {
        if (n_in != 21 || out_size != MTOK * DM || ws_size < WS_END) { fprintf(stderr, "kernel_launch: unexpected shapes (n_in %d, out %d, ws %zu)\n", n_in, out_size, ws_size); grid = -1; return; }
        int dev = 0, cus = 0, per_cu = 0;
        hipGetDevice(&dev); hipDeviceGetAttribute(&cus, hipDeviceAttributeMultiprocessorCount, dev);
        if (hipFuncSetAttribute((const void*)mk_fwd, hipFuncAttributeMaxDynamicSharedMemorySize, LDS_BYTES) != hipSuccess) { fprintf(stderr, "kernel_launch: hipFuncSetAttribute failed\n"); grid = -1; return; }
        if (hipOccupancyMaxActiveBlocksPerMultiprocessor(&per_cu, (const void*)mk_fwd, 512, LDS_BYTES) != hipSuccess || per_cu < 1) { fprintf(stderr, "kernel_launch: occupancy query gave %d\n", per_cu); per_cu = 1; }
        (void)hipGetLastError();
        grid = cus * 1;
        if (grid > 256) grid = 256;
    }
    if (grid < 0) return;
    Args a{};
    for (int i = 0; i < 21; ++i) a.in[i] = (const float*)d_in[i];
    a.out = (float*)d_out; a.ws = (unsigned char*)d_ws;
    if (hipMemsetAsync((char*)d_ws + WS_BAR, 0, BAR_BYTES, stream) != hipSuccess) { fprintf(stderr, "kernel_launch: memset failed\n"); return; }
#if MK_ONE_LAUNCH
    a.ph_lo = 0; a.ph_hi = NPHASE;
    void* args[] = {&a};
    hipError_t e = hipLaunchCooperativeKernel((const void*)mk_fwd, dim3(grid), dim3(512), args, LDS_BYTES, stream);
    if (e != hipSuccess) fprintf(stderr, "cooperative launch failed: %s (grid %d)\n", hipGetErrorString(e), grid);
#else
    for (int p = 0; p < NPHASE; ++p) { a.ph_lo = p; a.ph_hi = p + 1; hipLaunchKernelGGL(mk_fwd, dim3(grid), dim3(512), LDS_BYTES, stream, a); }
#endif
}
```
